# Optimizing an MI355X kernel written in HIP

```python
import math
import jax
import jax.numpy as jnp
from jax import lax
import numpy as np

D_MODEL = 1024
BATCH = 2
SEQ = 16384
DEPTH = 2
DEC_BATCH = 16
DEC_SEQ = 4096
PAST_LEN = 128

N_EVEN = (DEPTH + 1) // 2
N_ODD = DEPTH // 2

A_HEAD_DIM = 128
A_W = D_MODEL // 2
A_HEADS = A_W // A_HEAD_DIM
B_KEY_DIM = 64
B_VAL_DIM = 128
B_HEADS = (D_MODEL // 2) // B_VAL_DIM
B_K_W = B_HEADS * B_KEY_DIM
B_V_W = B_HEADS * B_VAL_DIM
GK_RANK = 16
GLA_GATE_NORM = 16.0
C_HEAD_DIM = 64
C_W = D_MODEL // 2
C_HEADS = C_W // C_HEAD_DIM
C_KV_HEADS = C_HEADS // 4
C_GROUP = C_HEADS // C_KV_HEADS
C_KV_W = C_KV_HEADS * C_HEAD_DIM
WINDOW = 128
ATT_BLOCK = 128
ROPE_THETA = 10000.0
D_HEAD_DIM = 64
D_W = D_MODEL // 2
D_HEADS = D_W // D_HEAD_DIM
W_RANK = 32
A_RANK = 32
RWKV_LN_EPS = 64e-5
CHUNK = 64
ALPHA = (2 * DEPTH) ** 0.25
BETA = (8 * DEPTH) ** -0.25

EV_SIZES = (A_W, A_W, A_W, A_W, A_W, B_K_W, B_K_W, B_V_W, GK_RANK, GK_RANK, B_V_W)
EV_IN = sum(EV_SIZES)
D_SIZES = (D_W, D_W, D_W, W_RANK, W_RANK, A_RANK, D_W)
D_SLAB = sum(D_SIZES)
OD_SIZES = (C_W, C_KV_W, C_KV_W, C_W, D_SLAB)
OD_IN = sum(OD_SIZES)

kernel_name = "hybrid_bidir_hgrn2_gla_swa_rwkv7_encoder"


def split_cols(u, sizes):
    return jnp.split(u, np.cumsum(sizes)[:-1].tolist(), axis=-1)


def layer_norm(x, g, b, eps=1e-5):
    xf = x.astype(jnp.float32)
    mu = jnp.mean(xf, axis=-1, keepdims=True)
    var = jnp.mean(jnp.square(xf - mu), axis=-1, keepdims=True)
    return ((xf - mu) * lax.rsqrt(var + eps) * g + b).astype(x.dtype)


def head_rms_norm(o, g, eps=1e-6):
    o = o * lax.rsqrt(jnp.mean(jnp.square(o), axis=-1, keepdims=True) + eps)
    return o.reshape(o.shape[0], o.shape[1], -1) * g


def modulate(x, c, w_mod, b_mod):
    shift, scale, gate = jnp.split(jax.nn.silu(c) @ w_mod + b_mod, 3, axis=-1)
    return x * (1.0 + scale[:, None]) + shift[:, None], gate[:, None]


def residual_post_norm(x, gate, y, ln_g, ln_b):
    return layer_norm(ALPHA * x + (1.0 + gate) * y, ln_g, ln_b)


def bidirectional(fn, fwd, bwd):
    bsz = fwd[0].shape[0]
    stacked = [jnp.concatenate([f, jnp.flip(b, axis=1)], axis=0) for f, b in zip(fwd, bwd)]
    o = fn(*stacked)
    return o[:bsz] + jnp.flip(o[bsz:], axis=1)


def chunk_gated_linear_attention(q, k, v, log_f):
    bsz, seq, heads, dk = q.shape
    n = seq // CHUNK
    shp = lambda t: t.astype(jnp.float32).reshape(bsz, n, CHUNK, heads, t.shape[-1])
    q, k, v, log_f = shp(q), shp(k), shp(v), shp(log_f)
    b = jnp.cumsum(log_f, axis=2)
    b_last = b[:, :, -1:]
    q_dec = q * jnp.exp(b)
    att = jnp.einsum('bnihk,bnjhk->bnhij', q_dec, k * jnp.exp(-b))
    att = jnp.where(jnp.tril(jnp.ones((CHUNK, CHUNK), bool)), att, 0.0)
    o_intra = jnp.einsum('bnhij,bnjhv->bnihv', att, v)
    k_end = k * jnp.exp(b_last - b)
    chunk_decay = jnp.exp(b_last[:, :, 0])

    def step(S, inp):
        q_c, k_c, v_c, d_c = inp
        o_c = jnp.einsum('bchk,bhkv->bchv', q_c, S)
        S = d_c[..., None] * S + jnp.einsum('bchk,bchv->bhkv', k_c, v_c)
        return S, o_c

    S0 = jnp.zeros((bsz, heads, dk, v.shape[-1]), jnp.float32)
    xs = tuple(jnp.moveaxis(t, 1, 0) for t in (q_dec, k_end, v, chunk_decay))
    _, o_inter = lax.scan(step, S0, xs)
    return (o_intra + jnp.moveaxis(o_inter, 0, 1)).reshape(bsz, seq, heads, -1)


def rotary(t):
    seq, hd = t.shape[1], t.shape[-1]
    inv = ROPE_THETA ** (-jnp.arange(0, hd, 2, dtype=jnp.float32) / hd)
    ang = jnp.arange(seq, dtype=jnp.float32)[:, None] * inv[None]
    cos, sin = jnp.cos(ang)[None, :, None, :], jnp.sin(ang)[None, :, None, :]
    t1, t2 = t[..., : hd // 2], t[..., hd // 2:]
    return jnp.concatenate([t1 * cos - t2 * sin, t2 * cos + t1 * sin], axis=-1).astype(t.dtype)


def banded_window_attention(q, k, v, sink):
    bsz, seq, _, hd = q.shape
    nb = seq // ATT_BLOCK
    qb = q.reshape(bsz, nb, ATT_BLOCK, C_KV_HEADS, C_GROUP, hd)

    def band(t):
        tp = jnp.pad(t.reshape(bsz, nb, ATT_BLOCK, C_KV_HEADS, hd), ((0, 0), (1, 1), (0, 0), (0, 0), (0, 0)))
        return jnp.concatenate([tp[:, :-2], tp[:, 1:-1], tp[:, 2:]], axis=2)

    kb, vb = band(k), band(v)
    s = jnp.einsum('bnigrd,bnjgd->bngrij', qb, kb).astype(jnp.float32) * (hd ** -0.5)
    i = jnp.arange(ATT_BLOCK)[:, None]
    j = jnp.arange(3 * ATT_BLOCK)[None, :]
    kpos = (jnp.arange(nb)[:, None, None] - 1) * ATT_BLOCK + j[None]
    valid = (jnp.abs(j - ATT_BLOCK - i)[None] <= WINDOW) & (kpos >= 0) & (kpos < seq)
    s = jnp.where(valid[None, :, None, None], s, -jnp.inf)
    sink_b = sink.astype(jnp.float32).reshape(C_KV_HEADS, C_GROUP)[None, None, :, :, None]
    lse = jnp.logaddexp(jax.nn.logsumexp(s, axis=-1), sink_b)
    p = jnp.exp(s - lse[..., None])
    o = jnp.einsum('bngrij,bnjgd->bnigrd', p.astype(vb.dtype), vb)
    return o.reshape(bsz, seq, C_HEADS, hd)


def rwkv7_scan(r, log_w, k, v, kk, a):
    bsz, _, heads, n = r.shape
    xs = tuple(jnp.moveaxis(t, 1, 0) for t in (r, jnp.exp(log_w), k, v, kk, kk * a))

    def step(S, inp):
        r_t, w_t, k_t, v_t, kk_t, b_t = inp
        s_kk = jnp.einsum('bhvk,bhk->bhv', S, kk_t)
        S = S * w_t[:, :, None, :] - s_kk[..., None] * b_t[:, :, None, :] + v_t[..., None] * k_t[:, :, None, :]
        return S, jnp.einsum('bhvk,bhk->bhv', S, r_t)

    S0 = jnp.zeros((bsz, heads, n, n), jnp.float32)
    _, o = lax.scan(step, S0, xs)
    return jnp.moveaxis(o, 0, 1)


def rwkv7_time_mix(z, mix, w0, w_w2, a0, a_w2, k_k, k_a, r_k, lnx_w, lnx_b):
    bsz, seq, _ = z.shape
    z_prev = jnp.pad(z[:, :-1], ((0, 0), (1, 0), (0, 0)))
    z_next = jnp.pad(z[:, 1:], ((0, 0), (0, 1), (0, 0)))
    z = z + mix[0] * (z_prev - z) + mix[1] * (z_next - z)
    r, k, v, wl_f, wl_b, al, g = split_cols(z, D_SIZES)

    def log_decay(wl, w0_d, w2_d):
        w = -jax.nn.softplus(-(w0_d + jnp.tanh(wl) @ w2_d).astype(jnp.float32)) - 0.5
        return -jnp.exp(w)

    hd = lambda t: t.astype(jnp.float32).reshape(bsz, seq, D_HEADS, D_HEAD_DIM)
    a = jax.nn.sigmoid((a0 + al @ a_w2).astype(jnp.float32))
    kk = hd(k * k_k)
    kk = kk / jnp.maximum(jnp.sqrt(jnp.sum(jnp.square(kk), axis=-1, keepdims=True)), 1e-12)
    k_mod = k.astype(jnp.float32) * (1.0 + (a - 1.0) * k_a)
    r_h, k_h, v_h, a_h = hd(r), hd(k_mod), hd(v), hd(a)
    o = bidirectional(rwkv7_scan,
                      (r_h, hd(log_decay(wl_f, w0[0], w_w2[0])), k_h, v_h, kk, a_h),
                      (r_h, hd(log_decay(wl_b, w0[1], w_w2[1])), k_h, v_h, kk, a_h))
    mu = jnp.mean(o, axis=-1, keepdims=True)
    var = jnp.mean(jnp.square(o - mu), axis=-1, keepdims=True)
    o = ((o - mu) * lax.rsqrt(var + RWKV_LN_EPS)).reshape(bsz, seq, D_W) * lnx_w + lnx_b
    bonus = jnp.sum(r_h * k_h * r_k.reshape(D_HEADS, D_HEAD_DIM), axis=-1, keepdims=True) * v_h
    return (o + bonus.reshape(bsz, seq, D_W)) * jax.nn.silu(g.astype(jnp.float32))


def even_layer(x, c, w_mod, b_mod, w_in, lb, hgrn_norm, gla_w_gk, gla_b_gk, gla_norm, w_out, ln_g, ln_b):
    bsz, seq, _ = x.shape
    h, gate = modulate(x, c, w_mod, b_mod)
    u = h @ w_in
    aq, ai, af_f, af_b, a_gate, bq, bk, bv, bl_f, bl_b, b_gate = split_cols(u, EV_SIZES)

    def hgrn_gates(zf, lb_d):
        f = lb_d + (1.0 - lb_d) * jax.nn.sigmoid(zf.astype(jnp.float32))
        return 1.0 - f, jnp.log(f)

    ak_f, alog_f = hgrn_gates(af_f, lb[0])
    ak_b, alog_b = hgrn_gates(af_b, lb[1])
    hA = lambda t: t.reshape(bsz, seq, A_HEADS, A_HEAD_DIM)
    aq = jax.nn.silu(aq)
    a_o = bidirectional(chunk_gated_linear_attention,
                        (hA(aq), hA(ak_f), hA(ai), hA(alog_f)),
                        (hA(aq), hA(ak_b), hA(ai), hA(alog_b)))
    a_out = head_rms_norm(a_o, hgrn_norm).astype(x.dtype) * jax.nn.silu(a_gate)

    def gla_log_decay(zl, w2, b2):
        return jax.nn.log_sigmoid((zl @ w2 + b2).astype(jnp.float32)) / GLA_GATE_NORM

    hBk = lambda t: t.reshape(bsz, seq, B_HEADS, B_KEY_DIM)
    hBv = lambda t: t.reshape(bsz, seq, B_HEADS, B_VAL_DIM)
    bq = bq * (B_KEY_DIM ** -0.5)
    b_o = bidirectional(chunk_gated_linear_attention,
                        (hBk(bq), hBk(bk), hBv(bv), hBk(gla_log_decay(bl_f, gla_w_gk[0], gla_b_gk[0]))),
                        (hBk(bq), hBk(bk), hBv(bv), hBk(gla_log_decay(bl_b, gla_w_gk[1], gla_b_gk[1]))))
    b_out = head_rms_norm(b_o, gla_norm).astype(x.dtype) * jax.nn.silu(b_gate)

    y = jnp.concatenate([a_out, b_out], axis=-1) @ w_out
    return residual_post_norm(x, gate, y, ln_g, ln_b)


def odd_layer(x, c, w_mod, b_mod, w_in, sink, mix, w0, w_w2, a0, a_w2, k_k, k_a, r_k, lnx_w, lnx_b,
              w_out, ln_g, ln_b):
    bsz, seq, _ = x.shape
    h, gate = modulate(x, c, w_mod, b_mod)
    u = h @ w_in
    cq, ck, cv, c_gate, d_slab = split_cols(u, OD_SIZES)

    q = rotary(cq.reshape(bsz, seq, C_HEADS, C_HEAD_DIM))
    k = rotary(ck.reshape(bsz, seq, C_KV_HEADS, C_HEAD_DIM))
    c_o = banded_window_attention(q, k, cv.reshape(bsz, seq, C_KV_HEADS, C_HEAD_DIM), sink)
    c_out = c_o.reshape(bsz, seq, C_W).astype(x.dtype) * jax.nn.silu(c_gate)

    d_out = rwkv7_time_mix(d_slab, mix, w0, w_w2, a0, a_w2, k_k, k_a, r_k, lnx_w, lnx_b).astype(x.dtype)

    y = jnp.concatenate([c_out, d_out], axis=-1) @ w_out
    return residual_post_norm(x, gate, y, ln_g, ln_b)


def trunk(x, c, ev_w_mod, ev_b_mod, ev_w_in, hgrn_lb_logits, hgrn_norm, gla_w_gk, gla_b_gk, gla_norm,
          ev_w_out, ev_ln_g, ev_ln_b, od_w_mod, od_b_mod, od_w_in, swa_sink, rwkv_mix, rwkv_w0, rwkv_w_w2,
          rwkv_a0, rwkv_a_w2, rwkv_k_k, rwkv_k_a, rwkv_r_k, rwkv_ln_w, rwkv_ln_b, od_w_out, od_ln_g, od_ln_b):
    lb_all = jnp.cumsum(jax.nn.softmax(hgrn_lb_logits.astype(jnp.float32), axis=1), axis=1)
    for layer in range(DEPTH):
        i = layer // 2
        if layer % 2 == 0:
            x = even_layer(x, c, ev_w_mod[i], ev_b_mod[i], ev_w_in[i], lb_all[:, i], hgrn_norm[i],
                           gla_w_gk[i], gla_b_gk[i], gla_norm[i], ev_w_out[i], ev_ln_g[i], ev_ln_b[i])
        else:
            x = odd_layer(x, c, od_w_mod[i], od_b_mod[i], od_w_in[i], swa_sink[i], rwkv_mix[i], rwkv_w0[i],
                          rwkv_w_w2[i], rwkv_a0[i], rwkv_a_w2[i], rwkv_k_k[i], rwkv_k_a[i], rwkv_r_k[i],
                          rwkv_ln_w[i], rwkv_ln_b[i], od_w_out[i], od_ln_g[i], od_ln_b[i])
    return x


def setup_inputs(seed: int = 0) -> dict:
    key = jax.random.key(seed)
    ks = iter(jax.random.split(key, 40))
    nrm = lambda shape, s: jax.random.normal(next(ks), shape, jnp.float32) * s
    D = D_MODEL
    NE, NO = N_EVEN, N_ODD
    return {
        "x_prompt": nrm((BATCH, SEQ, D), 1.0),
        "x_sample": nrm((DEC_BATCH, DEC_SEQ, D), 1.0),
        "c_prompt": nrm((BATCH, D), 1.0),
        "c_sample": nrm((DEC_BATCH, D), 1.0),
        "ev_w_mod": nrm((NE, D, 3 * D), 0.1 * D ** -0.5),
        "ev_b_mod": nrm((NE, 3 * D), 0.02),
        "ev_w_in": nrm((NE, D, EV_IN), D ** -0.5),
        "hgrn_lb_logits": nrm((2, NE + 1, A_W), 0.1),
        "hgrn_norm": 1.0 + nrm((NE, A_W), 0.01),
        "gla_w_gk": nrm((NE, 2, GK_RANK, B_K_W), GK_RANK ** -0.5),
        "gla_b_gk": nrm((NE, 2, B_K_W), 0.1),
        "gla_norm": 1.0 + nrm((NE, B_V_W), 0.01),
        "ev_w_out": nrm((NE, A_W + B_V_W, D), BETA * (A_W + B_V_W) ** -0.5),
        "ev_ln_g": 1.0 + nrm((NE, D), 0.01),
        "ev_ln_b": nrm((NE, D), 0.01),
        "od_w_mod": nrm((NO, D, 3 * D), 0.1 * D ** -0.5),
        "od_b_mod": nrm((NO, 3 * D), 0.02),
        "od_w_in": nrm((NO, D, OD_IN), D ** -0.5),
        "swa_sink": nrm((NO, C_HEADS), 0.5),
        "rwkv_mix": 0.5 * jax.random.uniform(next(ks), (NO, 2, D_SLAB), jnp.float32),
        "rwkv_w0": -1.0 + nrm((NO, 2, D_W), 0.5),
        "rwkv_w_w2": nrm((NO, 2, W_RANK, D_W), 0.5 * W_RANK ** -0.5),
        "rwkv_a0": nrm((NO, D_W), 0.1),
        "rwkv_a_w2": nrm((NO, A_RANK, D_W), 0.5 * A_RANK ** -0.5),
        "rwkv_k_k": 0.85 + nrm((NO, D_W), 0.02),
        "rwkv_k_a": 1.0 + nrm((NO, D_W), 0.02),
        "rwkv_r_k": nrm((NO, D_W), 0.1),
        "rwkv_ln_w": 1.0 + nrm((NO, D_W), 0.01),
        "rwkv_ln_b": nrm((NO, D_W), 0.01),
        "od_w_out": nrm((NO, C_W + D_W, D), BETA * (C_W + D_W) ** -0.5),
        "od_ln_g": 1.0 + nrm((NO, D), 0.01),
        "od_ln_b": nrm((NO, D), 0.01),
    }


def reference(x_prompt, x_sample, c_prompt, c_sample, ev_w_mod, ev_b_mod, ev_w_in, hgrn_lb_logits, hgrn_norm,
              gla_w_gk, gla_b_gk, gla_norm, ev_w_out, ev_ln_g, ev_ln_b, od_w_mod, od_b_mod, od_w_in, swa_sink,
              rwkv_mix, rwkv_w0, rwkv_w_w2, rwkv_a0, rwkv_a_w2, rwkv_k_k, rwkv_k_a, rwkv_r_k, rwkv_ln_w,
              rwkv_ln_b, od_w_out, od_ln_g, od_ln_b):
    weights = (ev_w_mod, ev_b_mod, ev_w_in, hgrn_lb_logits, hgrn_norm, gla_w_gk, gla_b_gk, gla_norm,
               ev_w_out, ev_ln_g, ev_ln_b, od_w_mod, od_b_mod, od_w_in, swa_sink, rwkv_mix, rwkv_w0,
               rwkv_w_w2, rwkv_a0, rwkv_a_w2, rwkv_k_k, rwkv_k_a, rwkv_r_k, rwkv_ln_w, rwkv_ln_b,
               od_w_out, od_ln_g, od_ln_b)
    y_prompt = trunk(x_prompt, c_prompt, *weights)
    y_sample = trunk(x_sample, c_sample, *weights)
    return (y_prompt, y_sample)
```

```cpp
#include <hip/hip_runtime.h>
#include <hip/hip_cooperative_groups.h>
#include <cstdio>
namespace cg = cooperative_groups;

#define DEVI __device__ __forceinline__
typedef unsigned short bf16_t;
typedef short bf16x8 __attribute__((ext_vector_type(8)));
typedef float f32x4 __attribute__((ext_vector_type(4)));

constexpr int D = 1024;
constexpr int NTOK = 98304, NPT = 32768;
constexpr int NSEQ = 18;
constexpr int EV_IN = 4128, EV_PAD = 4352;
constexpr int OD_IN = 3424, OD_PAD = 3584;
constexpr float ALPHA = 1.4142135623730951f;
constexpr int LDS_BYTES = 155648;
constexpr int NTHR = 512;

constexpr size_t al256(size_t x) { return (x + 255) & ~(size_t)255; }
constexpr size_t OFF_CNT = 0;
constexpr size_t OFF_LB = 4096;
constexpr size_t OFF_MOD = OFF_LB + 4096;
constexpr size_t OFF_BONUS = al256(OFF_MOD + (size_t)2 * NSEQ * 3072 * 4);
constexpr size_t OFF_ROPE = al256(OFF_BONUS + (size_t)NTOK * 8 * 4);
constexpr size_t OFF_WIN0 = al256(OFF_ROPE + (size_t)16384 * 32 * 8);
constexpr size_t OFF_WIN1 = al256(OFF_WIN0 + (size_t)EV_PAD * D * 2);
constexpr size_t OFF_WOUT0 = al256(OFF_WIN1 + (size_t)OD_PAD * D * 2);
constexpr size_t OFF_WOUT1 = al256(OFF_WOUT0 + (size_t)D * D * 2);
constexpr size_t OFF_H = al256(OFF_WOUT1 + (size_t)D * D * 2);
constexpr size_t OFF_U = al256(OFF_H + (size_t)NTOK * D * 2);
constexpr size_t OFF_OB1 = al256(OFF_U + (size_t)NTOK * OD_IN * 2);
constexpr size_t OFF_SLOC = al256(OFF_U + (size_t)NTOK * EV_IN * 2);
constexpr size_t OFF_DTOT = al256(OFF_SLOC + (size_t)224 * 128 * 128 * 4);
constexpr size_t OFF_BAR = al256(OFF_DTOT + (size_t)224 * 128 * 4);
constexpr size_t WS_NEED = OFF_BAR + 16384;
static_assert(WS_NEED <= (size_t)1073741824, "workspace fits 4x largest tensor");
static_assert(OFF_OB1 + (size_t)NTOK * 512 * 2 <= OFF_SLOC, "ob1 fits");

struct P {
  const float *x_prompt, *x_sample, *c_prompt, *c_sample;
  const float *ev_w_mod, *ev_b_mod, *ev_w_in, *lb_logits, *hgrn_norm, *gla_w_gk, *gla_b_gk, *gla_norm, *ev_w_out, *ev_ln_g, *ev_ln_b;
  const float *od_w_mod, *od_b_mod, *od_w_in, *swa_sink, *rwkv_mix, *rwkv_w0, *rwkv_w_w2, *rwkv_a0, *rwkv_a_w2, *rwkv_k_k, *rwkv_k_a,
      *rwkv_r_k, *rwkv_ln_w, *rwkv_ln_b, *od_w_out, *od_ln_g, *od_ln_b;
  float* out;
  unsigned char* ws;
  int ph_lo, ph_hi;
};

typedef float f32x2_t __attribute__((ext_vector_type(2)));
typedef __bf16 bf16x2_t __attribute__((ext_vector_type(2)));
DEVI unsigned pack2(float a, float b) { f32x2_t v = {a, b}; bf16x2_t r = __builtin_convertvector(v, bf16x2_t); return __builtin_bit_cast(unsigned, r); }
DEVI bf16_t f2bf(float f) { return (bf16_t)(pack2(f, 0.f) & 0xffffu); }
DEVI float bf2f(bf16_t h) { return __uint_as_float(((unsigned)h) << 16); }
DEVI float frcp(float x) { return __builtin_amdgcn_rcpf(x); }
DEVI float sigm(float x) { return frcp(1.f + __expf(-x)); }
DEVI float silu(float x) { return x * frcp(1.f + __expf(-x)); }
DEVI float softplusf(float x) { return x > 20.f ? x : __logf(1.f + __expf(x)); }
DEVI float ftanh(float x) { return 1.f - 2.f * frcp(1.f + __expf(2.f * x)); }
DEVI void seq_info(int s, int& L, int& tb) { if (s < 2) { L = 16384; tb = s * 16384; } else { L = 4096; tb = NPT + (s - 2) * 4096; } }
DEVI int tok_seq(int tok) { return tok < NPT ? (tok >> 14) : 2 + ((tok - NPT) >> 12); }
template <int CTRL> DEVI float dpp_f(float x) { return __builtin_bit_cast(float, __builtin_amdgcn_update_dpp(0, __builtin_bit_cast(int, x), CTRL, 0xf, 0xf, false)); }
DEVI float row16_sum(float x) {
  x += dpp_f<0xB1>(x);
  x += dpp_f<0x4E>(x);
  x += dpp_f<0x124>(x);
  x += dpp_f<0x128>(x);
  return x;
}
DEVI void reduce4_row16(float& a, float& b, float& c, float& d) {
  asm volatile(
      "s_nop 1\n\t"
      "v_add_f32_dpp %0, %0, %0 quad_perm:[1,0,3,2] row_mask:0xf bank_mask:0xf\n\t"
      "v_add_f32_dpp %1, %1, %1 quad_perm:[1,0,3,2] row_mask:0xf bank_mask:0xf\n\t"
      "v_add_f32_dpp %2, %2, %2 quad_perm:[1,0,3,2] row_mask:0xf bank_mask:0xf\n\t"
      "v_add_f32_dpp %3, %3, %3 quad_perm:[1,0,3,2] row_mask:0xf bank_mask:0xf\n\t"
      "v_add_f32_dpp %0, %0, %0 quad_perm:[2,3,0,1] row_mask:0xf bank_mask:0xf\n\t"
      "v_add_f32_dpp %1, %1, %1 quad_perm:[2,3,0,1] row_mask:0xf bank_mask:0xf\n\t"
      "v_add_f32_dpp %2, %2, %2 quad_perm:[2,3,0,1] row_mask:0xf bank_mask:0xf\n\t"
      "v_add_f32_dpp %3, %3, %3 quad_perm:[2,3,0,1] row_mask:0xf bank_mask:0xf\n\t"
      "v_add_f32_dpp %0, %0, %0 row_ror:4 row_mask:0xf bank_mask:0xf\n\t"
      "v_add_f32_dpp %1, %1, %1 row_ror:4 row_mask:0xf bank_mask:0xf\n\t"
      "v_add_f32_dpp %2, %2, %2 row_ror:4 row_mask:0xf bank_mask:0xf\n\t"
      "v_add_f32_dpp %3, %3, %3 row_ror:4 row_mask:0xf bank_mask:0xf\n\t"
      "v_add_f32_dpp %0, %0, %0 row_ror:8 row_mask:0xf bank_mask:0xf\n\t"
      "v_add_f32_dpp %1, %1, %1 row_ror:8 row_mask:0xf bank_mask:0xf\n\t"
      "v_add_f32_dpp %2, %2, %2 row_ror:8 row_mask:0xf bank_mask:0xf\n\t"
      "v_add_f32_dpp %3, %3, %3 row_ror:8 row_mask:0xf bank_mask:0xf\n\t"
      "s_nop 1"
      : "+v"(a), "+v"(b), "+v"(c), "+v"(d));
}
DEVI void reduce2_row16(float& a, float& b) {
  asm volatile(
      "s_nop 1\n\t"
      "v_add_f32_dpp %0, %0, %0 quad_perm:[1,0,3,2] row_mask:0xf bank_mask:0xf\n\t"
      "v_add_f32_dpp %1, %1, %1 quad_perm:[1,0,3,2] row_mask:0xf bank_mask:0xf\n\t"
      "s_nop 0\n\t"
      "v_add_f32_dpp %0, %0, %0 quad_perm:[2,3,0,1] row_mask:0xf bank_mask:0xf\n\t"
      "v_add_f32_dpp %1, %1, %1 quad_perm:[2,3,0,1] row_mask:0xf bank_mask:0xf\n\t"
      "s_nop 0\n\t"
      "v_add_f32_dpp %0, %0, %0 row_ror:4 row_mask:0xf bank_mask:0xf\n\t"
      "v_add_f32_dpp %1, %1, %1 row_ror:4 row_mask:0xf bank_mask:0xf\n\t"
      "s_nop 0\n\t"
      "v_add_f32_dpp %0, %0, %0 row_ror:8 row_mask:0xf bank_mask:0xf\n\t"
      "v_add_f32_dpp %1, %1, %1 row_ror:8 row_mask:0xf bank_mask:0xf\n\t"
      "s_nop 1"
      : "+v"(a), "+v"(b));
}
DEVI float wave_sum(float x) { for (int o = 32; o > 0; o >>= 1) x += __shfl_xor(x, o); return x; }

constexpr int BM = 256, BK = 64, HALF = 128, NXCD = 8, WGM = 8, HT = HALF * BK;
DEVI int lds_byte(int r, int c) { int st = (r >> 4) * 2 + (c >> 5), rr = r & 15, cc = c & 31, ob = rr * 64 + cc * 2; return st * 1024 + (ob ^ (((ob >> 9) & 1) << 5)); }
DEVI void stage_rc(int b, int& R, int& C) { int st = b / 1024, sb = b % 1024, swz = sb ^ (((sb >> 9) & 1) << 5); R = (st >> 1) * 16 + swz / 64; C = (st & 1) * 32 + (swz % 64) / 2; }

template <class Epi>
DEVI void gemm_phase(const bf16_t* __restrict__ A, const bf16_t* __restrict__ Bt, int M, int N, int K, const Epi& epi, char* smem) {
  bf16_t* shm = (bf16_t*)smem;
#define SA(b, h) (shm + ((b) * 2 + (h)) * HT)
#define SB(b, h) (shm + (4 + (b) * 2 + (h)) * HT)
#define STAGE(Pp, BASE, br, kt) do { const bf16_t* _gb = (BASE) + (long)(br) * K + (long)(kt) * BK; \
    __builtin_amdgcn_global_load_lds((const unsigned*)(_gb + soff0), (__attribute__((address_space(3))) unsigned*)((char*)(Pp) + threadIdx.x * 16), 16, 0, 0); \
    __builtin_amdgcn_global_load_lds((const unsigned*)(_gb + (long)64 * K + soff0), (__attribute__((address_space(3))) unsigned*)((char*)(Pp) + threadIdx.x * 16 + 8192), 16, 0, 0); } while (0)
#define LDA(dst, b, h) for (int m = 0; m < 4; ++m) for (int k = 0; k < 2; ++k) \
    dst[m][k] = *reinterpret_cast<const bf16x8*>((char*)SA(b, h) + aoff + (m * 2 + k) * 1024)
#define LDB(dst, b, h) for (int n = 0; n < 2; ++n) for (int k = 0; k < 2; ++k) \
    dst[n][k] = *reinterpret_cast<const bf16x8*>((char*)SB(b, h) + boff + (n * 2 + k) * 1024)
#define MMA(ai, bj, At_, Bt_) do { __builtin_amdgcn_s_setprio(1); \
    for (int m = 0; m < 4; ++m) for (int n = 0; n < 2; ++n) for (int k = 0; k < 2; ++k) \
      acc[ai][bj][m][n] = __builtin_amdgcn_mfma_f32_16x16x32_bf16(Bt_[n][k], At_[m][k], acc[ai][bj][m][n], 0, 0, 0); \
    __builtin_amdgcn_s_setprio(0); } while (0)
#define WAIT_V(n) asm volatile("s_waitcnt vmcnt(" #n ")" ::: "memory")
#define WAIT_L(n) asm volatile("s_waitcnt lgkmcnt(" #n ")" ::: "memory")
#define BAR __builtin_amdgcn_s_barrier()
#define SCHED __builtin_amdgcn_sched_barrier(0)
  const int nM = M / BM, nN = N / BM, nwg = nM * nN;
  const int wid = threadIdx.x >> 6, lane = threadIdx.x & 63, wr = wid >> 2, wc = wid & 3, fr = lane & 15, fq = lane >> 4;
  const int nt = K / BK;
  unsigned soff0;
  { int _r, _c; stage_rc(threadIdx.x * 16, _r, _c); soff0 = (unsigned)(_r * K + _c); }
  const int aoff = lds_byte(wr * 64 + fr, fq * 8), boff = lds_byte(wc * 32 + fr, fq * 8);
  for (int Lw = blockIdx.x; Lw < nwg; Lw += gridDim.x) {
    int wgid = Lw;
    { int q = nwg / NXCD, r = nwg % NXCD, xcd = wgid % NXCD, off = wgid / NXCD; wgid = (xcd < r ? xcd * (q + 1) : r * (q + 1) + (xcd - r) * q) + off; }
    int nig = WGM * nN, gid = wgid / nig, fm = gid * WGM, gsz = min(nM - fm, WGM);
    int pm = fm + ((wgid % nig) % gsz), pn = (wgid % nig) / gsz, brow = pm * BM, bcol = pn * BM;
    f32x4 acc[2][2][4][2] = {};
    bf16x8 At[4][2], B0[2][2], B1[2][2];
    STAGE(SB(0, 0), Bt, bcol, 0); STAGE(SA(0, 0), A, brow, 0);
    STAGE(SB(0, 1), Bt, bcol + HALF, 0); STAGE(SA(0, 1), A, brow + HALF, 0);
    if (wr == 1) BAR;
    WAIT_V(4); BAR;
    STAGE(SB(1, 0), Bt, bcol, 1); STAGE(SA(1, 0), A, brow, 1); STAGE(SB(1, 1), Bt, bcol + HALF, 1);
    WAIT_V(6); BAR;
    for (int t = 0; t < nt - 2; t += 2) {
      LDB(B0, 0, 0); SCHED; LDA(At, 0, 0); STAGE(SA(1, 1), A, brow + HALF, t + 1);
      WAIT_L(8); BAR; WAIT_L(0); MMA(0, 0, At, B0); BAR; SCHED;
      LDB(B1, 0, 1); STAGE(SB(0, 0), Bt, bcol, t + 2);
      BAR; WAIT_L(0); MMA(0, 1, At, B1); BAR;
      LDA(At, 0, 1); STAGE(SA(0, 0), A, brow, t + 2);
      BAR; WAIT_L(0); MMA(1, 0, At, B0); BAR; SCHED;
      STAGE(SB(0, 1), Bt, bcol + HALF, t + 2);
      WAIT_V(6); BAR; MMA(1, 1, At, B1); BAR;
      LDB(B0, 1, 0); SCHED; LDA(At, 1, 0); STAGE(SA(0, 1), A, brow + HALF, t + 2);
      WAIT_L(8); BAR; WAIT_L(0); MMA(0, 0, At, B0); BAR; SCHED;
      LDB(B1, 1, 1); STAGE(SB(1, 0), Bt, bcol, t + 3);
      BAR; WAIT_L(0); MMA(0, 1, At, B1); BAR;
      LDA(At, 1, 1); STAGE(SA(1, 0), A, brow, t + 3);
      BAR; WAIT_L(0); MMA(1, 0, At, B0); BAR; SCHED;
      STAGE(SB(1, 1), Bt, bcol + HALF, t + 3);
      WAIT_V(6); BAR; MMA(1, 1, At, B1); BAR;
    }
    { LDB(B0, 0, 0); LDA(At, 0, 0); STAGE(SA(1, 1), A, brow + HALF, nt - 1);
      BAR; WAIT_L(0); MMA(0, 0, At, B0); BAR;
      LDB(B1, 0, 1); BAR; WAIT_L(0); MMA(0, 1, At, B1); BAR;
      LDA(At, 0, 1); WAIT_V(4); BAR; WAIT_L(0); MMA(1, 0, At, B0); MMA(1, 1, At, B1); BAR; }
    { LDB(B0, 1, 0); LDA(At, 1, 0); WAIT_V(2); BAR; WAIT_L(0); MMA(0, 0, At, B0); BAR;
      LDB(B1, 1, 1); WAIT_V(0); BAR; WAIT_L(0); MMA(0, 1, At, B1); BAR;
      LDA(At, 1, 1); BAR; WAIT_L(0); MMA(1, 0, At, B0); MMA(1, 1, At, B1); BAR; }
    if (wr == 0) BAR;
#pragma unroll
    for (int ai = 0; ai < 2; ++ai)
#pragma unroll
      for (int m = 0; m < 4; ++m)
#pragma unroll
        for (int bj = 0; bj < 2; ++bj)
          epi(acc[ai][bj][m][0], acc[ai][bj][m][1], brow + ai * HALF + wr * 64 + m * 16 + fr, bcol + bj * HALF + wc * 32 + fq * 8);
    __syncthreads();
  }
#undef SA
#undef SB
#undef STAGE
#undef LDA
#undef LDB
#undef MMA
}

struct EpiU {
  bf16_t* U; int ldu; int nvalid; const float* LB; int act;
  DEVI void operator()(const f32x4& a0, const f32x4& a1, int row, int col) const {
    if (col < nvalid) {
      float v[8] = {a0[0], a0[1], a0[2], a0[3], a1[0], a1[1], a1[2], a1[3]};
      if (act) {
        if (col < 512) {
#pragma unroll
          for (int i = 0; i < 8; ++i) v[i] = silu(v[i]);
        } else if (col >= 1024 && col < 2048) {
          const float4 l0 = *(const float4*)(LB + (col - 1024)), l1 = *(const float4*)(LB + (col - 1024) + 4);
          const float lb[8] = {l0.x, l0.y, l0.z, l0.w, l1.x, l1.y, l1.z, l1.w};
#pragma unroll
          for (int i = 0; i < 8; ++i) v[i] = (1.f - lb[i]) * sigm(-v[i]);
        } else if (col >= 2560 && col < 2816) {
#pragma unroll
          for (int i = 0; i < 8; ++i) v[i] *= 0.125f;
        }
      }
      *(uint4*)(U + (size_t)row * ldu + col) = make_uint4(pack2(v[0], v[1]), pack2(v[2], v[3]), pack2(v[4], v[5]), pack2(v[6], v[7]));
    }
  }
};
struct EpiRes {
  const float* xp; const float* xs; float* out; const float* mod;
  DEVI void operator()(const f32x4& a, int row, int col) const {
    const float* xr = row < NPT ? xp + (size_t)row * D : xs + (size_t)(row - NPT) * D;
    float4 x = *(const float4*)(xr + col);
    float4 g = *(const float4*)(mod + tok_seq(row) * 3072 + 2048 + col);
    float4 o;
    o.x = ALPHA * x.x + (1.f + g.x) * a[0]; o.y = ALPHA * x.y + (1.f + g.y) * a[1];
    o.z = ALPHA * x.z + (1.f + g.z) * a[2]; o.w = ALPHA * x.w + (1.f + g.w) * a[3];
    *(float4*)(out + (size_t)row * D + col) = o;
  }
};

DEVI void phase_prep(const P& p, char* smem) {
  const int tid = threadIdx.x;
  unsigned char* ws = p.ws;
  if (blockIdx.x == 0) {
    if (tid < 64) ((unsigned*)(ws + OFF_CNT))[tid] = 0u;
    float* LB = (float*)(ws + OFF_LB);
    for (int i = tid; i < 1024; i += NTHR) { int dir = i >> 9, d = i & 511; float l0 = p.lb_logits[dir * 1024 + d], l1 = p.lb_logits[dir * 1024 + 512 + d]; LB[i] = 1.f / (1.f + __expf(l1 - l0)); }
  }
  {
    float2* R = (float2*)(ws + OFF_ROPE);
    for (int i = blockIdx.x * NTHR + tid; i < 16384 * 32; i += gridDim.x * NTHR) {
      int pos = i >> 5, j = i & 31;
      float inv = (float)exp(-(double)j * (9.210340371976184 / 32.0));
      float ang = (float)pos * inv;
      float sn, cs; sincosf(ang, &sn, &cs);
      R[i] = make_float2(cs, sn);
    }
  }
  constexpr int NJ_MOD = 48, T_IN0 = 16 * (EV_PAD / 64), T_IN1 = 16 * (OD_PAD / 64), T_OUT = 256, NJ = NJ_MOD + T_IN0 + T_IN1 + 2 * T_OUT;
  for (int job = blockIdx.x; job < NJ; job += gridDim.x) {
    if (job < NJ_MOD) {
      const int layer = job / 24, cgp = job % 24;
      const float* wm = layer ? p.od_w_mod : p.ev_w_mod; const float* bm = layer ? p.od_b_mod : p.ev_b_mod;
      float* SC = (float*)smem;
      float* RED = SC + NSEQ * 1024;
      for (int i = tid; i < NSEQ * 1024; i += NTHR) { int s_ = i >> 10, d = i & 1023; float c = s_ < 2 ? p.c_prompt[s_ * 1024 + d] : p.c_sample[(s_ - 2) * 1024 + d]; SC[i] = silu(c); }
      __syncthreads();
      const int oc = tid & 127, o = cgp * 128 + oc, dq = tid >> 7;
      float acc[NSEQ];
#pragma unroll
      for (int s_ = 0; s_ < NSEQ; ++s_) acc[s_] = 0.f;
#pragma unroll 8
      for (int d = dq * 256; d < dq * 256 + 256; ++d) {
        float wv = wm[(size_t)d * 3072 + o];
#pragma unroll
        for (int s_ = 0; s_ < NSEQ; ++s_) acc[s_] += SC[s_ * 1024 + d] * wv;
      }
#pragma unroll
      for (int s_ = 0; s_ < NSEQ; ++s_) RED[(dq * NSEQ + s_) * 128 + oc] = acc[s_];
      __syncthreads();
      float* MOD = (float*)(ws + OFF_MOD);
      for (int i = tid; i < NSEQ * 128; i += NTHR) {
        int s_ = i >> 7, c_ = i & 127;
        float v = RED[(0 * NSEQ + s_) * 128 + c_] + RED[(1 * NSEQ + s_) * 128 + c_] + RED[(2 * NSEQ + s_) * 128 + c_] + RED[(3 * NSEQ + s_) * 128 + c_];
        MOD[(size_t)(layer * NSEQ + s_) * 3072 + cgp * 128 + c_] = v + bm[cgp * 128 + c_];
      }
      __syncthreads();
    } else {
      int j = job - NJ_MOD; const float* W; bf16_t* dst; int N, Npad;
      if (j < T_IN0) { W = p.ev_w_in; dst = (bf16_t*)(ws + OFF_WIN0); N = EV_IN; Npad = EV_PAD; }
      else if ((j -= T_IN0) < T_IN1) { W = p.od_w_in; dst = (bf16_t*)(ws + OFF_WIN1); N = OD_IN; Npad = OD_PAD; }
      else if ((j -= T_IN1) < T_OUT) { W = p.ev_w_out; dst = (bf16_t*)(ws + OFF_WOUT0); N = 1024; Npad = 1024; }
      else { j -= T_OUT; W = p.od_w_out; dst = (bf16_t*)(ws + OFF_WOUT1); N = 1024; Npad = 1024; }
      const int ntn = Npad / 64, kt = j / ntn, ntile = j % ntn;
      float* T = (float*)smem;
      for (int i = tid; i < 4096; i += NTHR) { int kk = i >> 6, nn = i & 63; int n = ntile * 64 + nn; T[kk * 65 + nn] = n < N ? W[(size_t)(kt * 64 + kk) * N + n] : 0.f; }
      __syncthreads();
      for (int i = tid; i < 4096; i += NTHR) { int nn = i >> 6, kk = i & 63; { const int q = nn & 31, rho = (((q >> 2) & 1) << 4) | ((q >> 3) << 2) | (q & 3); dst[(size_t)(ntile * 64 + (nn & 32) + rho) * 1024 + kt * 64 + kk] = f2bf(T[kk * 65 + nn]); } }
      __syncthreads();
    }
  }
}

DEVI void phase_modulate0(const P& p) {
  const int lane = threadIdx.x & 63, gw = blockIdx.x * 8 + (threadIdx.x >> 6), nw = gridDim.x * 8;
  const float* MOD = (const float*)(p.ws + OFF_MOD);
  bf16_t* H = (bf16_t*)(p.ws + OFF_H);
  for (int row = gw; row < NTOK; row += nw) {
    const float* xr = row < NPT ? p.x_prompt + (size_t)row * D : p.x_sample + (size_t)(row - NPT) * D;
    const float* m = MOD + tok_seq(row) * 3072;
#pragma unroll
    for (int i = 0; i < 4; ++i) {
      int col = i * 256 + lane * 4;
      float4 x = *(const float4*)(xr + col), sh = *(const float4*)(m + col), sc = *(const float4*)(m + 1024 + col);
      uint2 o; o.x = pack2(x.x * (1.f + sc.x) + sh.x, x.y * (1.f + sc.y) + sh.y); o.y = pack2(x.z * (1.f + sc.z) + sh.z, x.w * (1.f + sc.w) + sh.w);
      *(uint2*)(H + (size_t)row * D + col) = o;
    }
  }
}

DEVI void phase_ln(const P& p, int layer) {
  const int lane = threadIdx.x & 63, gw = blockIdx.x * 8 + (threadIdx.x >> 6), nw = gridDim.x * 8;
  const float* MODL = (const float*)(p.ws + OFF_MOD) + (size_t)layer * NSEQ * 3072;
  const float* MOD1 = (const float*)(p.ws + OFF_MOD) + (size_t)NSEQ * 3072;
  bf16_t* H = (bf16_t*)(p.ws + OFF_H);
  const bf16_t* Y = (const bf16_t*)(p.ws + OFF_U);
  const float* lg = layer ? p.od_ln_g : p.ev_ln_g; const float* lb = layer ? p.od_ln_b : p.ev_ln_b;
  for (int row = gw; row < NTOK; row += nw) {
    float* xo = p.out + (size_t)row * D;
    const float* xr = layer ? xo : (row < NPT ? p.x_prompt + (size_t)row * D : p.x_sample + (size_t)(row - NPT) * D);
    const int sq = tok_seq(row);
    const float* mg = MODL + sq * 3072 + 2048;
    float4 v[4]; float sm = 0.f;
#pragma unroll
    for (int i = 0; i < 4; ++i) {
      const int col = i * 256 + lane * 4;
      const float4 x = *(const float4*)(xr + col), g = *(const float4*)(mg + col);
      const uint2 yv = *(const uint2*)(Y + (size_t)row * D + col);
      v[i].x = ALPHA * x.x + (1.f + g.x) * __uint_as_float(yv.x << 16); v[i].y = ALPHA * x.y + (1.f + g.y) * __uint_as_float(yv.x & 0xffff0000u);
      v[i].z = ALPHA * x.z + (1.f + g.z) * __uint_as_float(yv.y << 16); v[i].w = ALPHA * x.w + (1.f + g.w) * __uint_as_float(yv.y & 0xffff0000u);
      sm += v[i].x + v[i].y + v[i].z + v[i].w;
    }
    const float mu = wave_sum(sm) * (1.f / 1024.f);
    float sq2 = 0.f;
#pragma unroll
    for (int i = 0; i < 4; ++i) { float a = v[i].x - mu, b = v[i].y - mu, c = v[i].z - mu, d = v[i].w - mu; sq2 += a * a + b * b + c * c + d * d; }
    const float rs = rsqrtf(wave_sum(sq2) * (1.f / 1024.f) + 1e-5f);
    const float* m = MOD1 + sq * 3072;
#pragma unroll
    for (int i = 0; i < 4; ++i) {
      int col = i * 256 + lane * 4;
      float4 g = *(const float4*)(lg + col), b = *(const float4*)(lb + col), y;
      y.x = (v[i].x - mu) * rs * g.x + b.x; y.y = (v[i].y - mu) * rs * g.y + b.y; y.z = (v[i].z - mu) * rs * g.z + b.z; y.w = (v[i].w - mu) * rs * g.w + b.w;
      *(float4*)(xo + col) = y;
      if (layer == 0) {
        float4 sh = *(const float4*)(m + col), sc = *(const float4*)(m + 1024 + col);
        uint2 o; o.x = pack2(y.x * (1.f + sc.x) + sh.x, y.y * (1.f + sc.y) + sh.y); o.y = pack2(y.z * (1.f + sc.z) + sh.z, y.w * (1.f + sc.w) + sh.w);
        *(uint2*)(H + (size_t)row * D + col) = o;
      }
    }
  }
}

DEVI void unpack8(const uint4& a, float* o) {
  o[0] = __uint_as_float(a.x << 16); o[1] = __uint_as_float(a.x & 0xffff0000u); o[2] = __uint_as_float(a.y << 16); o[3] = __uint_as_float(a.y & 0xffff0000u);
  o[4] = __uint_as_float(a.z << 16); o[5] = __uint_as_float(a.z & 0xffff0000u); o[6] = __uint_as_float(a.w << 16); o[7] = __uint_as_float(a.w & 0xffff0000u);
}

DEVI void phase_combine0(const P& p) {
  const int lane = threadIdx.x & 63, gw = blockIdx.x * 8 + (threadIdx.x >> 6), nw = gridDim.x * 8;
  bf16_t* H = (bf16_t*)(p.ws + OFF_H);
  const bf16_t* OB = (const bf16_t*)p.out;
  const bf16_t* U = (const bf16_t*)(p.ws + OFF_U);
  const int c0 = lane * 16;
  const float* nw_ = c0 < 512 ? p.hgrn_norm + c0 : p.gla_norm + (c0 - 512);
  const int gcol = c0 < 512 ? 2048 + c0 : 3616 + (c0 - 512);
  float wn[16];
#pragma unroll
  for (int i = 0; i < 16; ++i) wn[i] = nw_[i];
  for (int row = gw; row < NTOK; row += nw) {
    float a[16], b[16], g[16];
    unpack8(*(const uint4*)(H + (size_t)row * D + c0), a); unpack8(*(const uint4*)(H + (size_t)row * D + c0 + 8), a + 8);
    unpack8(*(const uint4*)(OB + (size_t)row * D + c0), b); unpack8(*(const uint4*)(OB + (size_t)row * D + c0 + 8), b + 8);
    unpack8(*(const uint4*)(U + (size_t)row * EV_IN + gcol), g); unpack8(*(const uint4*)(U + (size_t)row * EV_IN + gcol + 8), g + 8);
    float ss = 0.f;
#pragma unroll
    for (int i = 0; i < 16; ++i) { a[i] += b[i]; ss += a[i] * a[i]; }
    ss += __shfl_xor(ss, 1); ss += __shfl_xor(ss, 2); ss += __shfl_xor(ss, 4);
    const float rs = rsqrtf(ss * (1.f / 128.f) + 1e-6f);
    uint4 o0, o1;
    float r[16];
#pragma unroll
    for (int i = 0; i < 16; ++i) r[i] = a[i] * rs * wn[i] * silu(g[i]);
    o0.x = pack2(r[0], r[1]); o0.y = pack2(r[2], r[3]); o0.z = pack2(r[4], r[5]); o0.w = pack2(r[6], r[7]);
    o1.x = pack2(r[8], r[9]); o1.y = pack2(r[10], r[11]); o1.z = pack2(r[12], r[13]); o1.w = pack2(r[14], r[15]);
    *(uint4*)(H + (size_t)row * D + c0) = o0; *(uint4*)(H + (size_t)row * D + c0 + 8) = o1;
  }
}

DEVI void phase_rwkv_post(const P& p) {
  const int lane = threadIdx.x & 63, gw = blockIdx.x * 8 + (threadIdx.x >> 6), nw = gridDim.x * 8;
  bf16_t* H = (bf16_t*)(p.ws + OFF_H);
  const bf16_t* OB = (const bf16_t*)(p.ws + OFF_OB1);
  const bf16_t* U = (const bf16_t*)(p.ws + OFF_U);
  const float* BON = (const float*)(p.ws + OFF_BONUS);
  const int c0 = lane * 8, hd_ = lane >> 3;
  float lw[8], lb[8], mv0[8], mv1[8], mg0[8], mg1[8];
#pragma unroll
  for (int i = 0; i < 8; ++i) {
    lw[i] = p.rwkv_ln_w[c0 + i]; lb[i] = p.rwkv_ln_b[c0 + i];
    mv0[i] = p.rwkv_mix[1024 + c0 + i]; mv1[i] = p.rwkv_mix[2144 + 1024 + c0 + i];
    mg0[i] = p.rwkv_mix[1632 + c0 + i]; mg1[i] = p.rwkv_mix[2144 + 1632 + c0 + i];
  }
  for (int row = gw; row < NTOK; row += nw) {
    int s = tok_seq(row), L, tb; seq_info(s, L, tb);
    const int pos = row - tb;
    float a[8], b[8], v[8], vp[8], vn[8], g[8], gp[8], gn[8];
    unpack8(*(const uint4*)(H + (size_t)row * D + 512 + c0), a);
    unpack8(*(const uint4*)(OB + (size_t)row * 512 + c0), b);
    const bf16_t* ur = U + (size_t)row * OD_IN;
    unpack8(*(const uint4*)(ur + 2304 + c0), v); unpack8(*(const uint4*)(ur + 2912 + c0), g);
    if (pos > 0) { unpack8(*(const uint4*)(ur - OD_IN + 2304 + c0), vp); unpack8(*(const uint4*)(ur - OD_IN + 2912 + c0), gp); }
    else {
#pragma unroll
      for (int i = 0; i < 8; ++i) { vp[i] = 0.f; gp[i] = 0.f; }
    }
    if (pos < L - 1) { unpack8(*(const uint4*)(ur + OD_IN + 2304 + c0), vn); unpack8(*(const uint4*)(ur + OD_IN + 2912 + c0), gn); }
    else {
#pragma unroll
      for (int i = 0; i < 8; ++i) { vn[i] = 0.f; gn[i] = 0.f; }
    }
    float sm = 0.f;
#pragma unroll
    for (int i = 0; i < 8; ++i) { a[i] += b[i]; sm += a[i]; }
    sm += __shfl_xor(sm, 1); sm += __shfl_xor(sm, 2); sm += __shfl_xor(sm, 4);
    const float mu = sm * (1.f / 64.f);
    float sq = 0.f;
#pragma unroll
    for (int i = 0; i < 8; ++i) { float d = a[i] - mu; sq += d * d; }
    sq += __shfl_xor(sq, 1); sq += __shfl_xor(sq, 2); sq += __shfl_xor(sq, 4);
    const float rs = rsqrtf(sq * (1.f / 64.f) + 64e-5f);
    const float bon = BON[(size_t)row * 8 + hd_];
    float r[8];
#pragma unroll
    for (int i = 0; i < 8; ++i) {
      float zv = v[i] + mv0[i] * (vp[i] - v[i]) + mv1[i] * (vn[i] - v[i]);
      float zg = g[i] + mg0[i] * (gp[i] - g[i]) + mg1[i] * (gn[i] - g[i]);
      r[i] = ((a[i] - mu) * rs * lw[i] + lb[i] + bon * zv) * silu(zg);
    }
    uint4 o; o.x = pack2(r[0], r[1]); o.y = pack2(r[2], r[3]); o.z = pack2(r[4], r[5]); o.w = pack2(r[6], r[7]);
    *(uint4*)(H + (size_t)row * D + 512 + c0) = o;
  }
}
#define MFMA16(a, b, c) __builtin_amdgcn_mfma_f32_16x16x32_bf16(a, b, c, 0, 0, 0)
template <int K, int MIX, int MODE, int DIR>
DEVI void scan0_task(const P& p, char* smem, int s, int h, int n0, int nc, int sbase, int g) {
  constexpr int dir = DIR;
  constexpr int TQ = 512 / K, TS = 64 / TQ, KS = K + 8, NKT = K / 16, NKS = K / 32;
  bf16_t* QD = (bf16_t*)smem;
  bf16_t* KI = QD + 64 * KS;
  bf16_t* KET = KI + 64 * KS;
  bf16_t* VT = KET + K * 72;
  bf16_t* ATT = VT + 128 * 72;
  bf16_t* ST = ATT + 64 * 72;
  float* PART = (float*)(ST + 128 * KS);
  float* DEC = PART + TQ * K;
  const int tid = threadIdx.x, lane = tid & 63, w = tid >> 6, fr = lane & 15, fq = lane >> 4;
  int L, tb; seq_info(s, L, tb);
  const bf16_t* U = (const bf16_t*)(p.ws + OFF_U);
  bf16_t* OUT = dir ? (bf16_t*)p.out : (bf16_t*)(p.ws + OFF_H);
  const int ocol = MIX * 512 + h * 128;
  const int k = tid % K, tq = tid / K;
  const int vc2 = tid & 63, vq8 = tid >> 6;
  const int vbase = MIX == 0 ? 512 + h * 128 : 3072 + h * 128;
  float lbv = 0.f, bgk = 0.f; float wg[16];
  if (MIX == 0) { lbv = ((const float*)(p.ws + OFF_LB))[dir * 512 + h * 128 + k];
#pragma unroll
    for (int j = 0; j < 16; ++j) wg[j] = 0.f;
  } else {
#pragma unroll
    for (int j = 0; j < 16; ++j) wg[j] = p.gla_w_gk[(dir * 16 + j) * 256 + h * 64 + k];
    bgk = p.gla_b_gk[dir * 256 + h * 64 + k];
  }
  __syncthreads();
  f32x4 accS[NKT];
#pragma unroll
  for (int i = 0; i < NKT; ++i) accS[i] = (f32x4){0.f, 0.f, 0.f, 0.f};
  float dsum = 0.f;
  if (MODE == 0) {
    for (int j = 0; j < g; ++j) {
      const float* SL = (const float*)(p.ws + OFF_SLOC) + (size_t)(sbase + j) * 16384;
      const float* DT = (const float*)(p.ws + OFF_DTOT) + (size_t)(sbase + j) * 128;
#pragma unroll
      for (int tk = 0; tk < NKT; ++tk) {
        const float dcy = __expf(DT[tk * 16 + fr]);
#pragma unroll
        for (int e = 0; e < 4; ++e) accS[tk][e] = accS[tk][e] * dcy + SL[(w * 16 + fq * 4 + e) * 128 + tk * 16 + fr];
      }
    }
#pragma unroll
    for (int tk = 0; tk < NKT; ++tk)
#pragma unroll
      for (int e = 0; e < 4; ++e) ST[(w * 16 + fq * 4 + e) * KS + tk * 16 + fr] = f2bf(accS[tk][e]);
  }
  const int NE = n0 + nc;
  float* BLS = DEC + K;
  unsigned short rq[TS], rf[TS]; unsigned rv[8];
  uint4 rbl = make_uint4(0u, 0u, 0u, 0u);
  auto issue = [&](int n) {
#pragma unroll
    for (int i = 0; i < TS; ++i) {
      const int tt = n * 64 + tq * TS + i; const int pos = dir ? L - 1 - tt : tt;
      const bf16_t* row = U + (size_t)(tb + pos) * EV_IN;
      if (MIX == 0) { if (MODE == 0) rq[i] = row[h * 128 + k]; rf[i] = row[1024 + dir * 512 + h * 128 + k]; }
      else { if (MODE == 0) rq[i] = row[2560 + h * 64 + k]; rf[i] = row[2816 + h * 64 + k]; }
    }
#pragma unroll
    for (int i = 0; i < 8; ++i) {
      const int tt = n * 64 + vq8 * 8 + i; const int pos = dir ? L - 1 - tt : tt;
      rv[i] = *(const unsigned*)(U + (size_t)(tb + pos) * EV_IN + vbase + 2 * vc2);
    }
    if (MIX == 1 && tid < 128) {
      const int tt = n * 64 + (tid >> 1); const int pos = dir ? L - 1 - tt : tt;
      rbl = *(const uint4*)(U + (size_t)(tb + pos) * EV_IN + 3584 + dir * 16 + (tid & 1) * 8);
    }
  };
  issue(n0);
  for (int n = n0; n < NE; ++n) {
    float cb[TS];
    float run = 0.f;
    if (MIX == 1) {
      if (tid < 128) { float bv[8]; unpack8(rbl, bv); float* d = BLS + (tid >> 1) * 16 + (tid & 1) * 8;
#pragma unroll
        for (int j = 0; j < 8; ++j) d[j] = bv[j]; }
      __syncthreads();
    }
#pragma unroll
    for (int i = 0; i < TS; ++i) {
      float lf;
      if (MIX == 0) {
        lf = __logf(1.f - bf2f(rf[i]));
      } else {
        const float4* bl = (const float4*)(BLS + (tq * TS + i) * 16);
        float z = bgk;
#pragma unroll
        for (int j = 0; j < 4; ++j) { float4 b4 = bl[j]; z += b4.x * wg[4 * j] + b4.y * wg[4 * j + 1] + b4.z * wg[4 * j + 2] + b4.w * wg[4 * j + 3]; }
        lf = (fminf(z, 0.f) - __logf(1.f + __expf(-fabsf(z)))) * (1.f / 16.f);
      }
      run += lf; cb[i] = run;
    }
    PART[tq * K + k] = run;
    {
      uint4 lo, hi;
      lo.x = (rv[0] & 0xffffu) | (rv[1] << 16); lo.y = (rv[2] & 0xffffu) | (rv[3] << 16); lo.z = (rv[4] & 0xffffu) | (rv[5] << 16); lo.w = (rv[6] & 0xffffu) | (rv[7] << 16);
      hi.x = (rv[0] >> 16) | (rv[1] & 0xffff0000u); hi.y = (rv[2] >> 16) | (rv[3] & 0xffff0000u); hi.z = (rv[4] >> 16) | (rv[5] & 0xffff0000u); hi.w = (rv[6] >> 16) | (rv[7] & 0xffff0000u);
      *(uint4*)(VT + (2 * vc2) * 72 + vq8 * 8) = lo; *(uint4*)(VT + (2 * vc2 + 1) * 72 + vq8 * 8) = hi;
    }
    __syncthreads();
    float pre = 0.f, tot = 0.f;
#pragma unroll
    for (int j = 0; j < TQ; ++j) { float v = PART[j * K + k]; tot += v; if (j < tq) pre += v; }
    const float etot = __expf(tot);
    if (tq == 0) { DEC[k] = etot; dsum += tot; }
    {
      unsigned pk[TS / 2];
#pragma unroll
      for (int i = 0; i < TS; i += 2) {
        const int t0 = tq * TS + i;
        const float k0 = bf2f(rf[i]), k1 = bf2f(rf[i + 1]);
        const float e0 = __expf(pre + cb[i]), e1 = __expf(pre + cb[i + 1]);
        const float ki0 = k0 * frcp(e0), ki1 = k1 * frcp(e1);
        if (MODE == 0) {
          QD[t0 * KS + k] = f2bf(bf2f(rq[i]) * e0); QD[(t0 + 1) * KS + k] = f2bf(bf2f(rq[i + 1]) * e1);
          KI[t0 * KS + k] = f2bf(ki0); KI[(t0 + 1) * KS + k] = f2bf(ki1);
        }
        pk[i / 2] = pack2(ki0 * etot, ki1 * etot);
      }
      uint4* dst = (uint4*)(KET + k * 72 + tq * TS);
      dst[0] = make_uint4(pk[0], pk[1], pk[2], pk[3]);
      if (TS == 16) dst[1] = make_uint4(pk[TS / 2 - 4], pk[TS / 2 - 3], pk[TS / 2 - 2], pk[TS / 2 - 1]);
    }
    if (n + 1 < NE) issue(n + 1);
    __syncthreads();
    if (MODE == 0) {
      const int ti = w >> 1;
#pragma unroll
      for (int c2 = 0; c2 < 2; ++c2) {
        const int tj = (w & 1) * 2 + c2;
        f32x4 a = {0.f, 0.f, 0.f, 0.f};
        if (tj <= ti) {
#pragma unroll
          for (int ks = 0; ks < NKS; ++ks) {
            bf16x8 kf = *(const bf16x8*)(KI + (tj * 16 + fr) * KS + ks * 32 + fq * 8);
            bf16x8 qf = *(const bf16x8*)(QD + (ti * 16 + fr) * KS + ks * 32 + fq * 8);
            a = MFMA16(kf, qf, a);
          }
        }
        const int i = ti * 16 + fr, j0 = tj * 16 + fq * 4;
        uint2 v; v.x = pack2(j0 <= i ? a[0] : 0.f, j0 + 1 <= i ? a[1] : 0.f); v.y = pack2(j0 + 2 <= i ? a[2] : 0.f, j0 + 3 <= i ? a[3] : 0.f);
        *(uint2*)(ATT + i * 72 + j0) = v;
      }
    }
    if (MODE == 0) __syncthreads();
    {
      const int tv = w;
      bf16x8 vf[2], sf[NKS];
#pragma unroll
      for (int ks = 0; ks < 2; ++ks) vf[ks] = *(const bf16x8*)(VT + (tv * 16 + fr) * 72 + ks * 32 + fq * 8);
      if (MODE == 0) {
#pragma unroll
      for (int ks = 0; ks < NKS; ++ks) sf[ks] = *(const bf16x8*)(ST + (tv * 16 + fr) * KS + ks * 32 + fq * 8);
#pragma unroll
      for (int ti = 0; ti < 4; ++ti) {
        f32x4 o = {0.f, 0.f, 0.f, 0.f};
#pragma unroll
        for (int ks = 0; ks < 2; ++ks) { bf16x8 af = *(const bf16x8*)(ATT + (ti * 16 + fr) * 72 + ks * 32 + fq * 8); o = MFMA16(vf[ks], af, o); }
#pragma unroll
        for (int ks = 0; ks < NKS; ++ks) { bf16x8 qf = *(const bf16x8*)(QD + (ti * 16 + fr) * KS + ks * 32 + fq * 8); o = MFMA16(sf[ks], qf, o); }
        const int tt = n * 64 + ti * 16 + fr; const int pos = dir ? L - 1 - tt : tt;
        uint2 ov; ov.x = pack2(o[0], o[1]); ov.y = pack2(o[2], o[3]);
        *(uint2*)(OUT + (size_t)(tb + pos) * D + ocol + tv * 16 + fq * 4) = ov;
      }
      }
#pragma unroll
      for (int tk = 0; tk < NKT; ++tk) {
        const float dc = DEC[tk * 16 + fr];
        f32x4 a = accS[tk]; a[0] *= dc; a[1] *= dc; a[2] *= dc; a[3] *= dc;
#pragma unroll
        for (int ks = 0; ks < 2; ++ks) { bf16x8 kf = *(const bf16x8*)(KET + (tk * 16 + fr) * 72 + ks * 32 + fq * 8); a = MFMA16(vf[ks], kf, a); }
        accS[tk] = a;
      }
    }
    __syncthreads();
    if (MODE == 0) {
      const int tv = w;
#pragma unroll
      for (int tk = 0; tk < NKT; ++tk)
#pragma unroll
        for (int e = 0; e < 4; ++e) ST[(tv * 16 + fq * 4 + e) * KS + tk * 16 + fr] = f2bf(accS[tk][e]);
    }
  }
  if (MODE == 1) {
    float* SL = (float*)(p.ws + OFF_SLOC) + (size_t)(sbase + g) * 16384;
#pragma unroll
    for (int tk = 0; tk < NKT; ++tk)
#pragma unroll
      for (int e = 0; e < 4; ++e) SL[(w * 16 + fq * 4 + e) * 128 + tk * 16 + fr] = accS[tk][e];
    if (tq == 0) ((float*)(p.ws + OFF_DTOT))[(size_t)(sbase + g) * 128 + k] = dsum;
  }
  __syncthreads();
}
template <int MODE, int DIR>
DEVI void rwkv_task(const P& p, char* smem, int s, int h, int n0, int nc, int sbase, int g) {
  constexpr int dir = DIR;
  bf16_t* QH = (bf16_t*)smem;
  bf16_t* RH = QH + 4 * 16 * 72;
  bf16_t* BT = RH + 4 * 16 * 72;
  bf16_t* KT = BT + 4 * 16 * 72;
  bf16_t* BKE = KT + 4 * 16 * 72;
  bf16_t* VB = BKE + 4 * 64 * 40;
  float* GT = (float*)(VB + 4 * 64 * 24);
  float* AU = GT + 4 * 64;
  bf16_t* NT = (bf16_t*)(AU + 4 * 256);
  float* OO = (float*)(NT + 4 * 256);
  float* SCAL = OO + 64 * 64;
  bf16_t* LOW = (bf16_t*)(SCAL + 256);
  const int tid = threadIdx.x, lane = tid & 63, w = tid >> 6, fr = lane & 15, fq = lane >> 4;
  int L, tb; seq_info(s, L, tb);
  const bf16_t* U = (const bf16_t*)(p.ws + OFF_U);
  const float* mix0 = p.rwkv_mix; const float* mix1 = p.rwkv_mix + 2144;
  const int hc0 = h * 64;
  const int tt = w >> 1;
  float* CT = (float*)(LOW + 64 * 72);
  bf16_t* W2T = (bf16_t*)(CT + 13 * 64);
  bf16_t* A2T = W2T + 64 * 40;
  __syncthreads();
  if (tid < 64) {
    const int c = hc0 + tid;
    CT[0 * 64 + tid] = p.rwkv_w0[dir * 512 + c]; CT[1 * 64 + tid] = p.rwkv_a0[c]; CT[2 * 64 + tid] = p.rwkv_k_k[c]; CT[3 * 64 + tid] = p.rwkv_k_a[c]; CT[4 * 64 + tid] = p.rwkv_r_k[c];
    { const int lcol_ = tid < 32 ? 2816 + dir * 32 + tid : 2880 + (tid - 32); CT[11 * 64 + tid] = mix0[lcol_ - 1280]; CT[12 * 64 + tid] = mix1[lcol_ - 1280]; }
    CT[5 * 64 + tid] = mix0[c]; CT[6 * 64 + tid] = mix1[c]; CT[7 * 64 + tid] = mix0[512 + c]; CT[8 * 64 + tid] = mix1[512 + c]; CT[9 * 64 + tid] = mix0[1024 + c]; CT[10 * 64 + tid] = mix1[1024 + c];
  }
  for (int i = tid; i < 64 * 32; i += NTHR) {
    const int j = i >> 6, c = i & 63;
    W2T[c * 40 + j] = f2bf(p.rwkv_w_w2[(size_t)(dir * 32 + j) * 512 + hc0 + c]);
    A2T[c * 40 + j] = f2bf(p.rwkv_a_w2[(size_t)j * 512 + hc0 + c]);
  }
  const int lc = tid & 63, tg = tid >> 6;
  f32x4 accS[4];
#pragma unroll
  for (int i = 0; i < 4; ++i) accS[i] = (f32x4){0.f, 0.f, 0.f, 0.f};
  const int wl = w & 3;
  if (MODE == 1 && w >= 4) {
#pragma unroll
    for (int tk = 0; tk < 4; ++tk)
#pragma unroll
      for (int e = 0; e < 4; ++e) accS[tk][e] = (tk * 16 + fq * 4 + e == wl * 16 + fr) ? 1.f : 0.f;
  }
  bf16_t* OUTB = dir ? (bf16_t*)(p.ws + OFF_OB1) : (bf16_t*)(p.ws + OFF_H);
  const int ostride = dir ? 512 : 1024, ocol = dir ? hc0 : 512 + hc0;
  float* BON = (float*)(p.ws + OFF_BONUS);
  const int NC = L / 64;
  bf16_t* RAW = A2T + 64 * 40;
  uint4 pre[5];
  auto issue = [&](int n) {
    const int Pb = dir ? L - 64 * (n + 1) : 64 * n;
    const bf16_t* ub = U + (size_t)(tb + Pb) * OD_IN;
#pragma unroll
    for (int j = 0; j < 5; ++j) {
      const int ui = threadIdx.x + j * NTHR, row = ui >> 5, sg = ui & 31;
      const int col = sg < 8 ? 1280 + hc0 + sg * 8 : sg < 16 ? 1792 + hc0 + (sg - 8) * 8 : sg < 24 ? 2304 + hc0 + (sg - 16) * 8 : sg < 28 ? 2816 + dir * 32 + (sg - 24) * 8 : 2880 + (sg - 28) * 8;
      const int pa = Pb + row - 1;
      pre[j] = make_uint4(0u, 0u, 0u, 0u);
      if (row < 66 && pa >= 0 && pa < L) pre[j] = *(const uint4*)(ub + (row - 1) * OD_IN + col);
    }
  };
  if (MODE == 0 && g > 0) {
    float* Sb = OO; float* Mb = (float*)RAW;
    const float* NM = (const float*)(p.ws + OFF_SLOC);
    const int fv = tid >> 3, fk = (tid & 7) * 8;
    __syncthreads();
    { const float* N0 = NM + (size_t)sbase * 8192 + fv * 64 + fk; *(float4*)(Sb + fv * 64 + fk) = *(const float4*)N0; *(float4*)(Sb + fv * 64 + fk + 4) = *(const float4*)(N0 + 4); }
    for (int j = 1; j < g; ++j) {
      const float* Nj = NM + (size_t)(sbase + j) * 8192; const float* Mj = Nj + 4096;
      *(float4*)(Mb + fv * 64 + fk) = *(const float4*)(Mj + fv * 64 + fk); *(float4*)(Mb + fv * 64 + fk + 4) = *(const float4*)(Mj + fv * 64 + fk + 4);
      float acc[8];
      { const float4 a0 = *(const float4*)(Nj + fv * 64 + fk), a1 = *(const float4*)(Nj + fv * 64 + fk + 4); acc[0] = a0.x; acc[1] = a0.y; acc[2] = a0.z; acc[3] = a0.w; acc[4] = a1.x; acc[5] = a1.y; acc[6] = a1.z; acc[7] = a1.w; }
      __syncthreads();
      for (int kp = 0; kp < 64; ++kp) {
        const float sv = Sb[fv * 64 + kp];
        const float4 m0 = *(const float4*)(Mb + kp * 64 + fk), m1 = *(const float4*)(Mb + kp * 64 + fk + 4);
        acc[0] += sv * m0.x; acc[1] += sv * m0.y; acc[2] += sv * m0.z; acc[3] += sv * m0.w; acc[4] += sv * m1.x; acc[5] += sv * m1.y; acc[6] += sv * m1.z; acc[7] += sv * m1.w;
      }
      __syncthreads();
      *(float4*)(Sb + fv * 64 + fk) = make_float4(acc[0], acc[1], acc[2], acc[3]); *(float4*)(Sb + fv * 64 + fk + 4) = make_float4(acc[4], acc[5], acc[6], acc[7]);
    }
    __syncthreads();
    if (w < 4) {
#pragma unroll
      for (int tk = 0; tk < 4; ++tk) { const float4 t4 = *(const float4*)(Sb + (w * 16 + fr) * 64 + tk * 16 + fq * 4); accS[tk][0] = t4.x; accS[tk][1] = t4.y; accS[tk][2] = t4.z; accS[tk][3] = t4.w; }
    }
    __syncthreads();
  }
  const int NE = n0 + nc;
  issue(n0);
  if (tid < 256) SCAL[tid] = 0.f;
  __syncthreads();
  for (int n = n0; n < NE; ++n) {
    const int Pbase = dir ? L - 64 * (n + 1) : 64 * n;
    int tid; asm volatile("v_mov_b32 %0, %1" : "=v"(tid) : "v"(threadIdx.x));
    const int lane = tid & 63, w = tid >> 6, fr = lane & 15, fq = lane >> 4, tt = w >> 1, lc = tid & 63, tg = tid >> 6, wl = w & 3;
#pragma unroll
    for (int j = 0; j < 5; ++j) { const int ui = tid + j * NTHR; if (ui < 66 * 32) *(uint4*)(RAW + (ui >> 5) * 264 + (ui & 31) * 8) = pre[j]; }
    __syncthreads();
    {
      float u[10];
      const float lm0 = CT[11 * 64 + lc], lm1 = CT[12 * 64 + lc];
#pragma unroll
      for (int i = 0; i < 10; ++i) u[i] = bf2f(RAW[(tg * 8 + i) * 264 + 192 + lc]);
#pragma unroll
      for (int i = 0; i < 8; ++i) {
        float z = u[i + 1] + lm0 * (u[i] - u[i + 1]) + lm1 * (u[i + 2] - u[i + 1]);
        if (lc < 32) z = ftanh(z);
        const int pc = tg * 8 + i, t = dir ? 63 - pc : pc;
        LOW[t * 72 + lc] = f2bf(z);
      }
    }
    const int tl = tt * 16 + fq * 4;
    const int pcl = dir ? 63 - (tl + 3) : tl;
    {
      float nsq[4] = {0.f, 0.f, 0.f, 0.f};
#pragma unroll
      for (int c2 = 0; c2 < 2; ++c2) {
        const int cl_ = ((w & 1) * 2 + c2) * 16 + fr;
        const float kkc_ = CT[128 + cl_], m0k_ = CT[448 + cl_], m1k_ = CT[512 + cl_];
        float uk[6];
#pragma unroll
        for (int i = 0; i < 6; ++i) uk[i] = bf2f(RAW[(pcl + i) * 264 + 64 + cl_]);
#pragma unroll
        for (int e = 0; e < 4; ++e) {
          const float ukc = dir ? uk[4 - e] : uk[1 + e], ukm = dir ? uk[3 - e] : uk[e], ukp = dir ? uk[5 - e] : uk[2 + e];
          const float kkraw = (ukc + m0k_ * (ukm - ukc) + m1k_ * (ukp - ukc)) * kkc_;
          nsq[e] += kkraw * kkraw;
        }
      }
      reduce4_row16(nsq[0], nsq[1], nsq[2], nsq[3]);
      if (fr == 0) {
#pragma unroll
        for (int e = 0; e < 4; ++e) atomicAdd(&SCAL[(tl + e) * 4 + 0], nsq[e]);
      }
    }
    __syncthreads();
    {
      const bf16x8 aW = *(const bf16x8*)(LOW + (tt * 16 + fr) * 72 + fq * 8);
      const bf16x8 aA = *(const bf16x8*)(LOW + (tt * 16 + fr) * 72 + 32 + fq * 8);
      float sbo[4] = {0.f, 0.f, 0.f, 0.f};
      float inv4[4];
#pragma unroll
      for (int e = 0; e < 4; ++e) inv4[e] = rsqrtf(fmaxf(SCAL[(tl + e) * 4], 1e-24f));
#pragma unroll
      for (int c2 = 0; c2 < 2; ++c2) {
        f32x4 z4 = {0.f, 0.f, 0.f, 0.f};
        const int cl = ((w & 1) * 2 + c2) * 16 + fr;
        f32x4 wd = MFMA16(aW, *(const bf16x8*)(W2T + cl * 40 + fq * 8), z4);
        f32x4 ad = MFMA16(aA, *(const bf16x8*)(A2T + cl * 40 + fq * 8), z4);
        float ur[6], uk[6], uv[6];
        const float w0c_ = CT[cl], a0c_ = CT[64 + cl], kkc_ = CT[128 + cl], kac_ = CT[192 + cl], rkc_ = CT[256 + cl];
        const float m0r_ = CT[320 + cl], m1r_ = CT[384 + cl], m0k_ = CT[448 + cl], m1k_ = CT[512 + cl], m0v_ = CT[576 + cl], m1v_ = CT[640 + cl];
#pragma unroll
        for (int i = 0; i < 6; ++i) { const bf16_t* rr = RAW + (pcl + i) * 264 + cl; ur[i] = bf2f(rr[0]); uk[i] = bf2f(rr[64]); uv[i] = bf2f(rr[128]); }
        float zr[4], wdc[4], kmv[4], zv4[4], kk4[4], b4[4];
#pragma unroll
        for (int e = 0; e < 4; ++e) {
          const float urc = dir ? ur[4 - e] : ur[1 + e], urm = dir ? ur[3 - e] : ur[e], urp = dir ? ur[5 - e] : ur[2 + e];
          const float ukc = dir ? uk[4 - e] : uk[1 + e], ukm = dir ? uk[3 - e] : uk[e], ukp = dir ? uk[5 - e] : uk[2 + e];
          const float uvc = dir ? uv[4 - e] : uv[1 + e], uvm = dir ? uv[3 - e] : uv[e], uvp = dir ? uv[5 - e] : uv[2 + e];
          const float r_ = urc + m0r_ * (urm - urc) + m1r_ * (urp - urc);
          const float k_ = ukc + m0k_ * (ukm - ukc) + m1k_ * (ukp - ukc);
          const float v_ = uvc + m0v_ * (uvm - uvc) + m1v_ * (uvp - uvc);
          const float a_ = sigm(a0c_ + ad[e]);
          zr[e] = r_; wdc[e] = __expf(-0.6065306597126334f * sigm(w0c_ + wd[e])); kmv[e] = k_ * (1.f + (a_ - 1.f) * kac_); zv4[e] = v_;
          kk4[e] = k_ * kkc_ * inv4[e]; b4[e] = kk4[e] * a_;
          sbo[e] += r_ * kmv[e] * rkc_;
        }
        float pr[4];
        pr[0] = wdc[0]; pr[1] = pr[0] * wdc[1]; pr[2] = pr[1] * wdc[2]; pr[3] = pr[2] * wdc[3];
        const float x = pr[3];
        float y = __shfl_up(x, 16); y = fq >= 1 ? x * y : x;
        float z = __shfl_up(y, 32); z = fq >= 2 ? y * z : y;
        float ex = __shfl_up(z, 16); ex = fq >= 1 ? ex : 1.f;
        const float gtot = __shfl(z, 48 + fr);
        float be[4], ke[4];
#pragma unroll
        for (int e = 0; e < 4; ++e) {
          const float Gt = ex * pr[e], Gm = e ? ex * pr[e > 0 ? e - 1 : 0] : ex;
          const float ig = frcp(Gt);
          const int ro = (tt * 16 + fq * 4 + e) * 72 + cl;
          QH[ro] = f2bf(Gm * kk4[e]); RH[ro] = f2bf(Gt * zr[e]);
          const float btl = b4[e] * ig, ktl = kmv[e] * ig;
          BT[ro] = f2bf(btl); KT[ro] = f2bf(ktl);
          be[e] = btl * gtot; ke[e] = ktl * gtot;
        }
        *(uint4*)(BKE + (tt * 64 + cl) * 40 + fq * 8) = make_uint4(pack2(be[0], be[1]), pack2(be[2], be[3]), pack2(ke[0], ke[1]), pack2(ke[2], ke[3]));
        *(uint2*)(VB + (tt * 64 + cl) * 24 + fq * 4) = make_uint2(pack2(zv4[0], zv4[1]), pack2(zv4[2], zv4[3]));
        if (fq == 0) GT[tt * 64 + cl] = gtot;
      }
      reduce4_row16(sbo[0], sbo[1], sbo[2], sbo[3]);
      if (fr == 0) {
#pragma unroll
        for (int e = 0; e < 4; ++e) atomicAdd(&SCAL[(tl + e) * 4 + 3], sbo[e]);
      }
    }
    __syncthreads();
    if (MODE == 0 && dir == 0 && tid < 64) BON[(size_t)(tb + Pbase + tid) * 8 + h] = SCAL[tid * 4 + 3];
#ifndef NO_PD
    int oz; asm volatile("v_mov_b32 %0, 0" : "=v"(oz));
    if (w >= 4) {
      const int bt = w - 4;
      f32x4 au = {0.f, 0.f, 0.f, 0.f};
#pragma unroll
      for (int ks = 0; ks < 2; ++ks) {
        const bf16x8 af = *(const bf16x8*)(BT + (bt * 16 + fr) * 72 + ks * 32 + fq * 8);
        const bf16x8 qf = *(const bf16x8*)(QH + (bt * 16 + fr) * 72 + ks * 32 + fq * 8);
        au = MFMA16(af, qf, au);
      }
#pragma unroll
      for (int e = 0; e < 4; ++e) AU[(bt * 16 + fq * 4 + e) * 16 + fr] = au[e];
      asm volatile("s_waitcnt lgkmcnt(0)" ::: "memory");
      const int ii = (lane & 15) + oz;
      float Y[16];
#pragma unroll
      for (int j = 0; j < 16; ++j) Y[j] = (j == ii) ? 1.f : 0.f;
#pragma unroll
      for (int k = 0; k < 15; ++k) {
        const float4* rowp = (const float4*)(AU + (bt * 16 + k) * 16);
        float rv[16];
#pragma unroll
        for (int q = 0; q < 4; ++q) { if (q * 4 + 3 > k) { const float4 t4 = rowp[q]; rv[q * 4] = t4.x; rv[q * 4 + 1] = t4.y; rv[q * 4 + 2] = t4.z; rv[q * 4 + 3] = t4.w; } }
#pragma unroll
        for (int j = k + 1; j < 16; ++j) Y[j] -= rv[j] * Y[k];
        if ((k & 3) == 3) __builtin_amdgcn_sched_barrier(0);
      }
      if (fq == 0) {
#pragma unroll
        for (int j = 0; j < 16; ++j) NT[(bt * 16 + j) * 16 + ii] = f2bf(-Y[j]);
      }
    }
#endif
    __syncthreads();
    if (tid < 256) SCAL[tid] = 0.f;
    if (n + 1 < NE) issue(n + 1);
#ifndef NO_PE
    if (w < 4 || MODE == 1) {
#pragma unroll
      for (int bt = 0; bt < 4; ++bt) {
        const bf16_t* qh = QH + (bt * 16 + fr) * 72; const bf16_t* rh = RH + (bt * 16 + fr) * 72;
        const bf16_t* bth = BT + (bt * 16 + fr) * 72; const bf16_t* kth = KT + (bt * 16 + fr) * 72;
        f32x4 avk = {0.f, 0.f, 0.f, 0.f}, br = avk, kr = avk;
#pragma unroll
        for (int ks = 0; ks < 2; ++ks) {
          const bf16x8 ktf = *(const bf16x8*)(kth + ks * 32 + fq * 8), btf = *(const bf16x8*)(bth + ks * 32 + fq * 8);
          const bf16x8 qf = *(const bf16x8*)(qh + ks * 32 + fq * 8), rf = *(const bf16x8*)(rh + ks * 32 + fq * 8);
          avk = MFMA16(ktf, qf, avk); br = MFMA16(btf, rf, br); kr = MFMA16(ktf, rf, kr);
        }
        bf16x8 sp[2], qa[2], ra[2];
#pragma unroll
        for (int m = 0; m < 2; ++m) {
#pragma unroll
          for (int e = 0; e < 4; ++e) { sp[m][e] = (short)f2bf(accS[2 * m][e]); sp[m][4 + e] = (short)f2bf(accS[2 * m + 1][e]); }
          const uint2 q0 = *(const uint2*)(qh + 32 * m + fq * 4), q1 = *(const uint2*)(qh + 32 * m + 16 + fq * 4);
          const uint2 r0 = *(const uint2*)(rh + 32 * m + fq * 4), r1 = *(const uint2*)(rh + 32 * m + 16 + fq * 4);
          qa[m] = __builtin_bit_cast(bf16x8, make_uint4(q0.x, q0.y, q1.x, q1.y));
          ra[m] = __builtin_bit_cast(bf16x8, make_uint4(r0.x, r0.y, r1.x, r1.y));
        }
        uint2 vv = *(const uint2*)(VB + (bt * 64 + wl * 16 + fr) * 24 + fq * 4);
        if (MODE == 1 && w >= 4) vv = make_uint2(0u, 0u);
        const uint2 ntv = *(const uint2*)(NT + (bt * 16 + fr) * 16 + fq * 4);
        const int i0 = fq * 4;
        const bf16x8 v_op = __builtin_bit_cast(bf16x8, make_uint4(0u, 0u, vv.x, vv.y));
        const bf16x8 avk_op = __builtin_bit_cast(bf16x8, make_uint4(0u, 0u, pack2(i0 < fr ? avk[0] : 0.f, i0 + 1 < fr ? avk[1] : 0.f), pack2(i0 + 2 < fr ? avk[2] : 0.f, i0 + 3 < fr ? avk[3] : 0.f)));
        f32x4 z4 = {0.f, 0.f, 0.f, 0.f};
        f32x4 W = MFMA16(qa[0], sp[0], z4); W = MFMA16(qa[1], sp[1], W); W = MFMA16(avk_op, v_op, W);
        const bf16x8 nt_op = __builtin_bit_cast(bf16x8, make_uint4(ntv.x, ntv.y, 0u, 0u));
        const bf16x8 w_op = __builtin_bit_cast(bf16x8, make_uint4(pack2(W[0], W[1]), pack2(W[2], W[3]), 0u, 0u));
        const f32x4 Uu = MFMA16(nt_op, w_op, z4);
        const bf16x8 uv_op = __builtin_bit_cast(bf16x8, make_uint4(pack2(Uu[0], Uu[1]), pack2(Uu[2], Uu[3]), vv.x, vv.y));
        const bf16x8 brkr_op = __builtin_bit_cast(bf16x8, make_uint4(pack2(i0 <= fr ? br[0] : 0.f, i0 + 1 <= fr ? br[1] : 0.f), pack2(i0 + 2 <= fr ? br[2] : 0.f, i0 + 3 <= fr ? br[3] : 0.f),
                                                                      pack2(i0 <= fr ? kr[0] : 0.f, i0 + 1 <= fr ? kr[1] : 0.f), pack2(i0 + 2 <= fr ? kr[2] : 0.f, i0 + 3 <= fr ? kr[3] : 0.f)));
        f32x4 O = MFMA16(ra[0], sp[0], z4); O = MFMA16(ra[1], sp[1], O); O = MFMA16(brkr_op, uv_op, O);
        if (MODE == 0) {
#pragma unroll
          for (int e = 0; e < 4; ++e) OO[(bt * 16 + fq * 4 + e) * 64 + w * 16 + fr] = O[e];
        }
#pragma unroll
        for (int tk = 0; tk < 4; ++tk) {
          const float4 g4 = *(const float4*)(GT + bt * 64 + tk * 16 + fq * 4);
          f32x4 a = accS[tk]; a[0] *= g4.x; a[1] *= g4.y; a[2] *= g4.z; a[3] *= g4.w;
          const bf16x8 bk = *(const bf16x8*)(BKE + (bt * 64 + tk * 16 + fr) * 40 + fq * 8);
          accS[tk] = MFMA16(bk, uv_op, a);
        }
      }
    }
#endif
    __syncthreads();
    if (MODE == 0) {
      const int t = tid >> 3, r8 = (tid & 7) * 8;
      const int pc = dir ? 63 - t : t;
      const float* src = OO + t * 64 + r8;
      uint4 o; o.x = pack2(src[0], src[1]); o.y = pack2(src[2], src[3]); o.z = pack2(src[4], src[5]); o.w = pack2(src[6], src[7]);
      *(uint4*)(OUTB + (size_t)(tb + Pbase + pc) * ostride + ocol + r8) = o;
    }
  }
  if (MODE == 1) {
    float* dst = (float*)(p.ws + OFF_SLOC) + (size_t)(sbase + g) * 8192 + (w >= 4 ? 4096 : 0);
#pragma unroll
    for (int tk = 0; tk < 4; ++tk) *(float4*)(dst + (wl * 16 + fr) * 64 + tk * 16 + fq * 4) = make_float4(accS[tk][0], accS[tk][1], accS[tk][2], accS[tk][3]);
  }
  __syncthreads();
}

DEVI void attn_task(const P& p, char* smem, int blk, int g) {
  bf16_t* KR = (bf16_t*)smem;
  bf16_t* VT = KR + 384 * 72;
  int tid; asm volatile("v_mov_b32 %0, %1" : "=v"(tid) : "v"(threadIdx.x));
  const int lane = tid & 63, w = tid >> 6, fr = lane & 15, fq = lane >> 4;
  const int tok0 = blk * 128, s = tok_seq(tok0);
  int L, tb; seq_info(s, L, tb);
  const int nb = (tok0 - tb) >> 7;
  const float2* ROPE = (const float2*)(p.ws + OFF_ROPE);
  const bf16_t* U = (const bf16_t*)(p.ws + OFF_U);
  bf16_t* H = (bf16_t*)(p.ws + OFF_H);
  __syncthreads();
#pragma unroll 4
  for (int it = 0; it < 24; ++it) {
    const int i = tid + it * NTHR;
    const int key = i >> 5, d = i & 31, kpos = (nb - 1) * 128 + key;
    const bool ok = kpos >= 0 && kpos < L;
    const int kc = kpos < 0 ? 0 : (kpos >= L ? L - 1 : kpos);
    const bf16_t* row = U + (size_t)(tb + kc) * OD_IN + 512 + g * 64;
    const float a = bf2f(row[d]), b = bf2f(row[d + 32]); const float2 cs = ROPE[kc * 32 + d];
    const float k1 = ok ? a * cs.x - b * cs.y : 0.f, k2 = ok ? b * cs.x + a * cs.y : 0.f;
    KR[key * 72 + d] = f2bf(k1); KR[key * 72 + d + 32] = f2bf(k2);
  }
#pragma unroll 8
  for (int it = 0; it < 48; ++it) {
    const int i = tid + it * NTHR;
    const int key = i >> 6, d = i & 63, kpos = (nb - 1) * 128 + key;
    const bool ok = kpos >= 0 && kpos < L;
    const int kc = kpos < 0 ? 0 : (kpos >= L ? L - 1 : kpos);
    const bf16_t v = U[(size_t)(tb + kc) * OD_IN + 640 + g * 64 + d];
    VT[d * 392 + key] = ok ? v : (bf16_t)0;
  }
  __syncthreads();
  const int hq = g * 4 + (w >> 1);
  const float sink = p.swa_sink[hq];
  uint4 rqa, rqb; float4 rcs[4];
  auto issue_q = [&](int mt_) {
    const int qp = nb * 128 + (w & 1) * 64 + mt_ * 16 + fr;
    const bf16_t* row = U + ((size_t)tb + qp) * OD_IN + hq * 64;
    rqa = *(const uint4*)(row + fq * 8); rqb = *(const uint4*)(row + 32 + fq * 8);
    const float4* rp = (const float4*)(ROPE + qp * 32 + fq * 8);
    rcs[0] = rp[0]; rcs[1] = rp[1]; rcs[2] = rp[2]; rcs[3] = rp[3];
  };
  issue_q(0);
  for (int mt = 0; mt < 4; ++mt) {
    const int qloc = (w & 1) * 64 + mt * 16 + fr, qpos = nb * 128 + qloc;
    const size_t tokq = (size_t)tb + qpos;
    bf16x8 qf[2];
    {
      float qa[8], qb[8]; unpack8(rqa, qa); unpack8(rqb, qb);
#pragma unroll
      for (int j = 0; j < 4; ++j) {
        const float4 cs = rcs[j];
        qf[0][2 * j] = (short)f2bf((qa[2 * j] * cs.x - qb[2 * j] * cs.y) * 0.125f); qf[1][2 * j] = (short)f2bf((qb[2 * j] * cs.x + qa[2 * j] * cs.y) * 0.125f);
        qf[0][2 * j + 1] = (short)f2bf((qa[2 * j + 1] * cs.z - qb[2 * j + 1] * cs.w) * 0.125f); qf[1][2 * j + 1] = (short)f2bf((qb[2 * j + 1] * cs.z + qa[2 * j + 1] * cs.w) * 0.125f);
      }
    }
    if (mt < 3) issue_q(mt + 1);
    const int q16 = (w & 1) * 4 + mt;
    f32x4 sc[17];
#pragma unroll
    for (int i = 0; i < 17; ++i) {
      const int nt = q16 + i;
      f32x4 a = {0.f, 0.f, 0.f, 0.f};
#pragma unroll
      for (int ks = 0; ks < 2; ++ks) { bf16x8 kf = *(const bf16x8*)(KR + (nt * 16 + fr) * 72 + ks * 32 + fq * 8); a = MFMA16(kf, qf[ks], a); }
      sc[i] = a;
    }
    float m = sink;
#pragma unroll
    for (int i = 0; i < 17; ++i)
#pragma unroll
      for (int e = 0; e < 4; ++e) {
        const int key = (q16 + i) * 16 + fq * 4 + e, rel = key - 128 - qloc, kpos = (nb - 1) * 128 + key;
        const bool valid = rel >= -128 && rel <= 128 && kpos >= 0 && kpos < L;
        sc[i][e] = valid ? sc[i][e] : -1e30f;
        m = fmaxf(m, sc[i][e]);
      }
    m = fmaxf(m, __shfl_xor(m, 16)); m = fmaxf(m, __shfl_xor(m, 32));
    float sum = 0.f;
#pragma unroll
    for (int i = 0; i < 17; ++i)
#pragma unroll
      for (int e = 0; e < 4; ++e) { const float pv = __expf(sc[i][e] - m); sc[i][e] = pv; sum += pv; }
    sum += __shfl_xor(sum, 16); sum += __shfl_xor(sum, 32);
    const float rden = 1.f / (sum + __expf(sink - m));
    f32x4 o[4];
#pragma unroll
    for (int dt = 0; dt < 4; ++dt) o[dt] = (f32x4){0.f, 0.f, 0.f, 0.f};
#pragma unroll
    for (int mm = 0; mm < 9; ++mm) {
      bf16x8 pf;
#pragma unroll
      for (int e = 0; e < 4; ++e) { pf[e] = (short)f2bf(sc[2 * mm][e]); pf[4 + e] = mm < 8 ? (short)f2bf(sc[mm < 8 ? 2 * mm + 1 : 16][e]) : (short)0; }
      const int k0 = (q16 + 2 * mm) * 16 + fq * 4, k1 = (mm < 8 ? (q16 + 2 * mm + 1) : q16) * 16 + fq * 4;
#pragma unroll
      for (int dt = 0; dt < 4; ++dt) {
        const bf16_t* vr = VT + (dt * 16 + fr) * 392;
        const uint2 lo = *(const uint2*)(vr + k0), hi = *(const uint2*)(vr + k1);
        uint4 pk = make_uint4(lo.x, lo.y, hi.x, hi.y);
        o[dt] = MFMA16(__builtin_bit_cast(bf16x8, pk), pf, o[dt]);
      }
    }
#pragma unroll
    for (int dt = 0; dt < 4; ++dt) {
      const int d0 = dt * 16 + fq * 4;
      const uint2 gv = *(const uint2*)(U + tokq * OD_IN + 768 + hq * 64 + d0);
      const float g0 = __uint_as_float(gv.x << 16), g1 = __uint_as_float(gv.x & 0xffff0000u), g2 = __uint_as_float(gv.y << 16), g3 = __uint_as_float(gv.y & 0xffff0000u);
      uint2 ov; ov.x = pack2(o[dt][0] * rden * silu(g0), o[dt][1] * rden * silu(g1)); ov.y = pack2(o[dt][2] * rden * silu(g2), o[dt][3] * rden * silu(g3));
      *(uint2*)(H + tokq * D + hq * 64 + d0) = ov;
    }
  }
  __syncthreads();
}
#define XB_TMO      128
#define XB_XCNT(j)  (256  + 64 * (j))
#define XB_XSUB(j)  (1280 + 64 * (j))
#define XB_XGEN(j)  (2304 + 64 * (j))
#define XB_TOP      3328
#define XB_TOPGEN   3392
#define XCD_BAR_WORDS 3456
#define XB_SPIN_CAP (1u << 18)
#define XLAS __attribute__((address_space(3)))

__device__ __forceinline__ unsigned xb_ld(unsigned* p)              { return __hip_atomic_load(p, __ATOMIC_RELAXED, __HIP_MEMORY_SCOPE_AGENT); }
__device__ __forceinline__ unsigned xb_add(unsigned* p, unsigned v) { return __hip_atomic_fetch_add(p, v, __ATOMIC_RELAXED, __HIP_MEMORY_SCOPE_AGENT); }
__device__ __forceinline__ unsigned xb_xcc_id() { return (unsigned)__builtin_amdgcn_s_getreg((3 << 11) | 20) & 0xFu; }
#define XB_SPIN(cond, bar) do { unsigned _sp = 0; while (cond) { __builtin_amdgcn_s_sleep(1); \
    if ((++_sp & 255u) == 0u) { if (xb_ld(&(bar)[XB_TMO])) break; if (_sp > XB_SPIN_CAP) { atomicAdd(&(bar)[XB_TMO], 1u); break; } } } } while (0)

struct XcdBarrier {
    unsigned* bar; unsigned x;
    volatile XLAS unsigned* st;
};

__device__ __forceinline__ XcdBarrier xcd_barrier_post(unsigned* bar, volatile XLAS unsigned* st) {
    XcdBarrier b; b.bar = bar; b.x = xb_xcc_id(); b.st = st;
    if (threadIdx.x == 0) (void)xb_add(&bar[XB_XCNT(b.x)], 1u);
    return b;
}
__device__ __forceinline__ void xcd_barrier_complete(unsigned* bar, unsigned x, unsigned& nloc, unsigned& nx) {
    const unsigned G = gridDim.x * gridDim.y * gridDim.z;
    unsigned sum, cnt, mine, sp = 0u;
    for (;;) {
        sum = 0u; cnt = 0u; mine = 0u;
#pragma unroll
        for (unsigned j = 0; j < 16; ++j) { const unsigned c = xb_ld(&bar[XB_XCNT(j)]); sum += c; cnt += (c > 0u) ? 1u : 0u; mine = (j == x) ? c : mine; }
        if (sum == G) break;
        __builtin_amdgcn_s_sleep(1);
        if ((++sp & 255u) == 0u) { if (xb_ld(&bar[XB_TMO])) break; if (sp > XB_SPIN_CAP) { atomicAdd(&bar[XB_TMO], 1u); break; } }
    }
    nloc = mine > 0u ? mine : 1u; nx = cnt > 0u ? cnt : 1u;
}

__device__ __forceinline__ void xcd_barrier(const XcdBarrier& b) {
    asm volatile("s_waitcnt vmcnt(0)" ::: "memory");
    __syncthreads();
    if (threadIdx.x == 0) {
        unsigned* bar = b.bar;
        __builtin_amdgcn_s_waitcnt(0);
        unsigned nloc = b.st[0], nx = b.st[1];
        if (nloc == 0u) { xcd_barrier_complete(bar, b.x, nloc, nx); b.st[0] = nloc; b.st[1] = nx; }
        const unsigned old = xb_add(&bar[XB_XSUB(b.x)], 1u);
        const unsigned gen = old / nloc;
        if (old + 1u == (gen + 1u) * nloc) {
            __builtin_amdgcn_fence(__ATOMIC_RELEASE, "agent");
            asm volatile("s_waitcnt vmcnt(0)" ::: "memory");
            const unsigned og = xb_add(&bar[XB_TOP], 1u);
            const unsigned tg = og / nx;
            if (og + 1u == (tg + 1u) * nx) xb_add(&bar[XB_TOPGEN], 1u);
            else XB_SPIN(xb_ld(&bar[XB_TOPGEN]) == tg, bar);
            __builtin_amdgcn_fence(__ATOMIC_ACQUIRE, "agent");
            xb_add(&bar[XB_XGEN(b.x)], 1u);
            asm volatile("s_waitcnt vmcnt(0)" ::: "memory");
        } else {
            XB_SPIN(xb_ld(&bar[XB_XGEN(b.x)]) == gen, bar);
            __builtin_amdgcn_fence(__ATOMIC_ACQUIRE, "agent");
            asm volatile("s_waitcnt vmcnt(0)" ::: "memory");
        }
    }
    __syncthreads();
}


#ifndef PHMASK
#define PHMASK 0xFFF
#endif
DEVI int next_task(unsigned* cnt, int* sh) { __syncthreads(); if (threadIdx.x == 0) *sh = (int)atomicAdd(cnt, 1u); __syncthreads(); return *sh; }
DEVI void decode_chain(int id, int& s, int& rem) { if (id < 32) { s = id >> 4; rem = id & 15; } else { s = 2 + ((id - 32) >> 4); rem = (id - 32) & 15; } }

__global__ void __launch_bounds__(512, 2) mega(P p) {
  extern __shared__ __attribute__((aligned(16))) char smem[];
  __shared__ uint4 xb_words;
  if (threadIdx.x == 0) xb_words = make_uint4(0u, 0u, 0u, 0u);
  __syncthreads();
  const XcdBarrier xb = xcd_barrier_post((unsigned*)(p.ws + OFF_BAR), (volatile XLAS unsigned*)&xb_words);
  int& sh_task = *((int*)&xb_words + 2);
  cg::grid_group grid = cg::this_grid();
  unsigned* cnt = (unsigned*)(p.ws + OFF_CNT);
  const bf16_t* Hc = (const bf16_t*)(p.ws + OFF_H);
  const float* MOD = (const float*)(p.ws + OFF_MOD);
#ifndef DUPMASK
#define DUPMASK 0
#endif
#define PH_ON(k) ((PHMASK & (1 << (k))) && p.ph_lo <= (k) && (k) < p.ph_hi)
#define REP(k) for (int rep_ = 0; rep_ < ((DUPMASK >> (k)) & 1) + 1; ++rep_)
#define PH_SYNC(k) if (p.ph_lo <= (k) && (k) + 1 < p.ph_hi) { if ((k) == 0) grid.sync(); else xcd_barrier(xb); }
  if (PH_ON(0)) REP(0) phase_prep(p, smem);
  PH_SYNC(0);
  if (PH_ON(1)) REP(1) phase_modulate0(p);
  PH_SYNC(1);
  if (PH_ON(2)) REP(2) { EpiU e{(bf16_t*)(p.ws + OFF_U), EV_IN, EV_IN, (const float*)(p.ws + OFF_LB), 1}; gemm_phase(Hc, (const bf16_t*)(p.ws + OFF_WIN0), NTOK, EV_PAD, D, e, smem); }
  PH_SYNC(2);
#ifndef DUP3
#define DUP3 1
#endif
#ifndef DUP8
#define DUP8 1
#endif
  if (PH_ON(3)) {
    int id;
    while ((id = next_task(cnt + 2, &sh_task)) < 224) {
      const int ci = id / 7, g = id % 7, s = ci >> 4, rem = ci & 15, h = (rem >> 1) & 3, dir = rem & 1;
      if ((rem >> 3) == 0) { if (dir) scan0_task<128, 0, 1, 1>(p, smem, s, h, g * 32, 32, ci * 7, g); else scan0_task<128, 0, 1, 0>(p, smem, s, h, g * 32, 32, ci * 7, g); }
      else { if (dir) scan0_task<64, 1, 1, 1>(p, smem, s, h, g * 32, 32, ci * 7, g); else scan0_task<64, 1, 1, 0>(p, smem, s, h, g * 32, 32, ci * 7, g); }
    }
    xcd_barrier(xb);
    while ((id = next_task(cnt + 3, &sh_task)) < 512) {
      int s, rem, n0 = 0, nc = 64, sb = 0, g = 0;
      if (id < 256) { s = 2 + (id >> 4); rem = id & 15; }
      else { const int a = id - 256, ci = a >> 3; g = a & 7; s = ci >> 4; rem = ci & 15; n0 = g * 32; nc = 32; sb = ci * 7; }
      const int h = (rem >> 1) & 3, dir = rem & 1;
      if ((rem >> 3) == 0) { if (dir) scan0_task<128, 0, 0, 1>(p, smem, s, h, n0, nc, sb, g); else scan0_task<128, 0, 0, 0>(p, smem, s, h, n0, nc, sb, g); }
      else { if (dir) scan0_task<64, 1, 0, 1>(p, smem, s, h, n0, nc, sb, g); else scan0_task<64, 1, 0, 0>(p, smem, s, h, n0, nc, sb, g); }
    }
  }
  PH_SYNC(3);
  if (PH_ON(4)) phase_combine0(p);
  PH_SYNC(4);
  if (PH_ON(5)) REP(5) { EpiU e{(bf16_t*)(p.ws + OFF_U), D, D, (const float*)(p.ws + OFF_LB), 0}; gemm_phase(Hc, (const bf16_t*)(p.ws + OFF_WOUT0), NTOK, D, D, e, smem); }
  PH_SYNC(5);
  if (PH_ON(6)) phase_ln(p, 0);
  PH_SYNC(6);
  if (PH_ON(7)) REP(7) { EpiU e{(bf16_t*)(p.ws + OFF_U), OD_IN, OD_IN, (const float*)(p.ws + OFF_LB), 0}; gemm_phase(Hc, (const bf16_t*)(p.ws + OFF_WIN1), NTOK, OD_PAD, D, e, smem); }
  PH_SYNC(7);
  if (PH_ON(8)) {
    int id;
#ifndef NO_R0
    while ((id = next_task(cnt + 16, &sh_task)) < 256) { if (id & 1) rwkv_task<0, 1>(p, smem, 2 + (id >> 4), (id & 15) >> 1, 0, 64, 0, 0); else rwkv_task<0, 0>(p, smem, 2 + (id >> 4), (id & 15) >> 1, 0, 64, 0, 0); }
#endif
#ifndef NO_R1
    while ((id = next_task(cnt + 19, &sh_task)) < 224) { const int ci = id / 7, g = id % 7; if (ci & 1) rwkv_task<1, 1>(p, smem, ci >> 4, (ci & 15) >> 1, g * 32, 32, ci * 7, g); else rwkv_task<1, 0>(p, smem, ci >> 4, (ci & 15) >> 1, g * 32, 32, ci * 7, g); }
#endif
    while ((id = next_task(cnt + 18, &sh_task)) < 768) attn_task(p, smem, id >> 1, id & 1);
    xcd_barrier(xb);
#ifndef NO_R2
    while ((id = next_task(cnt + 17, &sh_task)) < 256) { const int ci = id >> 3, g = id & 7; if (ci & 1) rwkv_task<0, 1>(p, smem, ci >> 4, (ci & 15) >> 1, g * 32, 32, ci * 7, g); else rwkv_task<0, 0>(p, smem, ci >> 4, (ci & 15) >> 1, g * 32, 32, ci * 7, g); }
#endif
    while ((id = next_task(cnt + 20, &sh_task)) < 768) attn_task(p, smem, (id + 768) >> 1, id & 1);
  }
  PH_SYNC(8);
  if (PH_ON(9)) phase_rwkv_post(p);
  PH_SYNC(9);
  if (PH_ON(10)) { EpiU e{(bf16_t*)(p.ws + OFF_U), D, D, (const float*)(p.ws + OFF_LB), 0}; gemm_phase(Hc, (const bf16_t*)(p.ws + OFF_WOUT1), NTOK, D, D, e, smem); }
  PH_SYNC(10);
  if (PH_ON(11)) phase_ln(p, 1);
}

constexpr int NPH = 12;
constexpr bool ONE_LAUNCH = true;
extern "C" void kernel_launch(void* const* d_in, const int* in_sizes, int n_in, void* d_out, int out_size, void* d_ws, size_t ws_size, hipStream_t stream) {
  P p{};
  const float** f = (const float**)&p;
  for (int i = 0; i < 32; ++i) f[i] = (const float*)d_in[i];
  p.out = (float*)d_out; p.ws = (unsigned char*)d_ws; p.ph_lo = 0; p.ph_hi = NPH;
  static int grid_blocks = 0;
  if (!grid_blocks) {
    (void)hipFuncSetAttribute((const void*)mega, hipFuncAttributeMaxDynamicSharedMemorySize, LDS_BYTES);
    int dev = 0, cus = 0, per_cu = 0;
    (void)hipGetDevice(&dev);
    (void)hipDeviceGetAttribute(&cus, hipDeviceAttributeMultiprocessorCount, dev);
    (void)hipOccupancyMaxActiveBlocksPerMultiprocessor(&per_cu, mega, NTHR, LDS_BYTES);
    if (per_cu > 1) per_cu = 1;
    grid_blocks = cus * per_cu;
  }
  if (ws_size < WS_NEED || grid_blocks <= 0) { fprintf(stderr, "ws too small or no occupancy: %zu < %zu, grid %d\n", ws_size, WS_NEED, grid_blocks); return; }
  if (ONE_LAUNCH) {
    (void)hipMemsetAsync((unsigned char*)d_ws + OFF_BAR, 0, 16384, stream);
    void* args[] = {&p};
    hipError_t e = hipLaunchCooperativeKernel((void*)mega, dim3(grid_blocks), dim3(NTHR), args, LDS_BYTES, stream);
    if (e != hipSuccess) fprintf(stderr, "cooperative launch failed: %s (grid %d)\n", hipGetErrorString(e), grid_blocks);
  } else {
    for (int ph = 0; ph < NPH; ++ph) { P q = p; q.ph_lo = ph; q.ph_hi = ph + 1; hipLaunchKernelGGL(mega, dim3(grid_blocks), dim3(NTHR), LDS_BYTES, stream, q); }
  }
}
```

```cpp
#include <hip/hip_runtime.h>
#include <hip/hip_cooperative_groups.h>
#include <cstdio>
namespace cg = cooperative_groups;

#define DEVI __device__ __forceinline__
typedef unsigned short bf16_t;
typedef short bf16x8 __attribute__((ext_vector_type(8)));
typedef float f32x4 __attribute__((ext_vector_type(4)));

constexpr int D = 1024;
constexpr int NTOK = 98304, NPT = 32768;
constexpr int NSEQ = 18;
constexpr int EV_IN = 4128, EV_PAD = 4352;
constexpr int OD_IN = 3424, OD_PAD = 3584;
constexpr float ALPHA = 1.4142135623730951f;
constexpr int LDS_BYTES = 155648;
constexpr int NTHR = 512;

constexpr size_t al256(size_t x) { return (x + 255) & ~(size_t)255; }
constexpr size_t OFF_CNT = 0;
constexpr size_t OFF_LB = 4096;
constexpr size_t OFF_MOD = OFF_LB + 4096;
constexpr size_t OFF_BONUS = al256(OFF_MOD + (size_t)2 * NSEQ * 3072 * 4);
constexpr size_t OFF_ROPE = al256(OFF_BONUS + (size_t)NTOK * 8 * 4);
constexpr size_t OFF_WIN0 = al256(OFF_ROPE + (size_t)16384 * 32 * 8);
constexpr size_t OFF_WIN1 = al256(OFF_WIN0 + (size_t)EV_PAD * D * 2);
constexpr size_t OFF_WOUT0 = al256(OFF_WIN1 + (size_t)OD_PAD * D * 2);
constexpr size_t OFF_WOUT1 = al256(OFF_WOUT0 + (size_t)D * D * 2);
constexpr size_t OFF_H = al256(OFF_WOUT1 + (size_t)D * D * 2);
constexpr size_t OFF_U = al256(OFF_H + (size_t)NTOK * D * 2);
constexpr size_t OFF_OB1 = al256(OFF_U + (size_t)NTOK * OD_IN * 2);
constexpr size_t OFF_SLOC = al256(OFF_U + (size_t)NTOK * EV_IN * 2);
constexpr size_t OFF_DTOT = al256(OFF_SLOC + (size_t)224 * 128 * 128 * 4);
constexpr size_t OFF_BAR = al256(OFF_DTOT + (size_t)224 * 128 * 4);
constexpr size_t WS_NEED = OFF_BAR + 16384;
static_assert(WS_NEED <= (size_t)1073741824, "workspace fits 4x largest tensor");
static_assert(OFF_OB1 + (size_t)NTOK * 512 * 2 <= OFF_SLOC, "ob1 fits");

struct P {
  const float *x_prompt, *x_sample, *c_prompt, *c_sample;
  const float *ev_w_mod, *ev_b_mod, *ev_w_in, *lb_logits, *hgrn_norm, *gla_w_gk, *gla_b_gk, *gla_norm, *ev_w_out, *ev_ln_g, *ev_ln_b;
  const float *od_w_mod, *od_b_mod, *od_w_in, *swa_sink, *rwkv_mix, *rwkv_w0, *rwkv_w_w2, *rwkv_a0, *rwkv_a_w2, *rwkv_k_k, *rwkv_k_a,
      *rwkv_r_k, *rwkv_ln_w, *rwkv_ln_b, *od_w_out, *od_ln_g, *od_ln_b;
  float* out;
  unsigned char* ws;
  int ph_lo, ph_hi;
};

typedef float f32x2_t __attribute__((ext_vector_type(2)));
typedef __bf16 bf16x2_t __attribute__((ext_vector_type(2)));
DEVI unsigned pack2(float a, float b) { f32x2_t v = {a, b}; bf16x2_t r = __builtin_convertvector(v, bf16x2_t); return __builtin_bit_cast(unsigned, r); }
DEVI bf16_t f2bf(float f) { return (bf16_t)(pack2(f, 0.f) & 0xffffu); }
DEVI float bf2f(bf16_t h) { return __uint_as_float(((unsigned)h) << 16); }
DEVI float frcp(float x) { return __builtin_amdgcn_rcpf(x); }
DEVI float sigm(float x) { return frcp(1.f + __expf(-x)); }
DEVI float silu(float x) { return x * frcp(1.f + __expf(-x)); }
DEVI float softplusf(float x) { return x > 20.f ? x : __logf(1.f + __expf(x)); }
DEVI float ftanh(float x) { return 1.f - 2.f * frcp(1.f + __expf(2.f * x)); }
DEVI void seq_info(int s, int& L, int& tb) { if (s < 2) { L = 16384; tb = s * 16384; } else { L = 4096; tb = NPT + (s - 2) * 4096; } }
DEVI int tok_seq(int tok) { return tok < NPT ? (tok >> 14) : 2 + ((tok - NPT) >> 12); }
template <int CTRL> DEVI float dpp_f(float x) { return __builtin_bit_cast(float, __builtin_amdgcn_update_dpp(0, __builtin_bit_cast(int, x), CTRL, 0xf, 0xf, false)); }
DEVI float row16_sum(float x) {
  x += dpp_f<0xB1>(x);
  x += dpp_f<0x4E>(x);
  x += dpp_f<0x124>(x);
  x += dpp_f<0x128>(x);
  return x;
}
DEVI void reduce4_row16(float& a, float& b, float& c, float& d) {
  asm volatile(
      "s_nop 1\n\t"
      "v_add_f32_dpp %0, %0, %0 quad_perm:[1,0,3,2] row_mask:0xf bank_mask:0xf\n\t"
      "v_add_f32_dpp %1, %1, %1 quad_perm:[1,0,3,2] row_mask:0xf bank_mask:0xf\n\t"
      "v_add_f32_dpp %2, %2, %2 quad_perm:[1,0,3,2] row_mask:0xf bank_mask:0xf\n\t"
      "v_add_f32_dpp %3, %3, %3 quad_perm:[1,0,3,2] row_mask:0xf bank_mask:0xf\n\t"
      "v_add_f32_dpp %0, %0, %0 quad_perm:[2,3,0,1] row_mask:0xf bank_mask:0xf\n\t"
      "v_add_f32_dpp %1, %1, %1 quad_perm:[2,3,0,1] row_mask:0xf bank_mask:0xf\n\t"
      "v_add_f32_dpp %2, %2, %2 quad_perm:[2,3,0,1] row_mask:0xf bank_mask:0xf\n\t"
      "v_add_f32_dpp %3, %3, %3 quad_perm:[2,3,0,1] row_mask:0xf bank_mask:0xf\n\t"
      "v_add_f32_dpp %0, %0, %0 row_ror:4 row_mask:0xf bank_mask:0xf\n\t"
      "v_add_f32_dpp %1, %1, %1 row_ror:4 row_mask:0xf bank_mask:0xf\n\t"
      "v_add_f32_dpp %2, %2, %2 row_ror:4 row_mask:0xf bank_mask:0xf\n\t"
      "v_add_f32_dpp %3, %3, %3 row_ror:4 row_mask:0xf bank_mask:0xf\n\t"
      "v_add_f32_dpp %0, %0, %0 row_ror:8 row_mask:0xf bank_mask:0xf\n\t"
      "v_add_f32_dpp %1, %1, %1 row_ror:8 row_mask:0xf bank_mask:0xf\n\t"
      "v_add_f32_dpp %2, %2, %2 row_ror:8 row_mask:0xf bank_mask:0xf\n\t"
      "v_add_f32_dpp %3, %3, %3 row_ror:8 row_mask:0xf bank_mask:0xf\n\t"
      "s_nop 1"
      : "+v"(a), "+v"(b), "+v"(c), "+v"(d));
}
DEVI void reduce2_row16(float& a, float& b) {
  asm volatile(
      "s_nop 1\n\t"
      "v_add_f32_dpp %0, %0, %0 quad_perm:[1,0,3,2] row_mask:0xf bank_mask:0xf\n\t"
      "v_add_f32_dpp %1, %1, %1 quad_perm:[1,0,3,2] row_mask:0xf bank_mask:0xf\n\t"
      "s_nop 0\n\t"
      "v_add_f32_dpp %0, %0, %0 quad_perm:[2,3,0,1] row_mask:0xf bank_mask:0xf\n\t"
      "v_add_f32_dpp %1, %1, %1 quad_perm:[2,3,0,1] row_mask:0xf bank_mask:0xf\n\t"
      "s_nop 0\n\t"
      "v_add_f32_dpp %0, %0, %0 row_ror:4 row_mask:0xf bank_mask:0xf\n\t"
      "v_add_f32_dpp %1, %1, %1 row_ror:4 row_mask:0xf bank_mask:0xf\n\t"
      "s_nop 0\n\t"
      "v_add_f32_dpp %0, %0, %0 row_ror:8 row_mask:0xf bank_mask:0xf\n\t"
      "v_add_f32_dpp %1, %1, %1 row_ror:8 row_mask:0xf bank_mask:0xf\n\t"
      "s_nop 1"
      : "+v"(a), "+v"(b));
}
DEVI float wave_sum(float x) { for (int o = 32; o > 0; o >>= 1) x += __shfl_xor(x, o); return x; }

constexpr int BM = 256, BK = 64, HALF = 128, NXCD = 8, WGM = 8, HT = HALF * BK;
DEVI int lds_byte(int r, int c) { int st = (r >> 4) * 2 + (c >> 5), rr = r & 15, cc = c & 31, ob = rr * 64 + cc * 2; return st * 1024 + (ob ^ (((ob >> 9) & 1) << 5)); }
DEVI void stage_rc(int b, int& R, int& C) { int st = b / 1024, sb = b % 1024, swz = sb ^ (((sb >> 9) & 1) << 5); R = (st >> 1) * 16 + swz / 64; C = (st & 1) * 32 + (swz % 64) / 2; }

template <class Epi>
DEVI void gemm_phase(const bf16_t* __restrict__ A, const bf16_t* __restrict__ Bt, int M, int N, int K, const Epi& epi, char* smem) {
  bf16_t* shm = (bf16_t*)smem;
#define SA(b, h) (shm + ((b) * 2 + (h)) * HT)
#define SB(b, h) (shm + (4 + (b) * 2 + (h)) * HT)
#define STAGE(Pp, BASE, br, kt) do { const bf16_t* _gb = (BASE) + (long)(br) * K + (long)(kt) * BK; \
    __builtin_amdgcn_global_load_lds((const unsigned*)(_gb + soff0), (__attribute__((address_space(3))) unsigned*)((char*)(Pp) + threadIdx.x * 16), 16, 0, 0); \
    __builtin_amdgcn_global_load_lds((const unsigned*)(_gb + (long)64 * K + soff0), (__attribute__((address_space(3))) unsigned*)((char*)(Pp) + threadIdx.x * 16 + 8192), 16, 0, 0); } while (0)
#define LDA(dst, b, h) for (int m = 0; m < 4; ++m) for (int k = 0; k < 2; ++k) \
    dst[m][k] = *reinterpret_cast<const bf16x8*>((char*)SA(b, h) + aoff + (m * 2 + k) * 1024)
#define LDB(dst, b, h) for (int n = 0; n < 2; ++n) for (int k = 0; k < 2; ++k) \
    dst[n][k] = *reinterpret_cast<const bf16x8*>((char*)SB(b, h) + boff + (n * 2 + k) * 1024)
#define MMA(ai, bj, At_, Bt_) do { __builtin_amdgcn_s_setprio(1); \
    for (int m = 0; m < 4; ++m) for (int n = 0; n < 2; ++n) for (int k = 0; k < 2; ++k) \
      acc[ai][bj][m][n] = __builtin_amdgcn_mfma_f32_16x16x32_bf16(Bt_[n][k], At_[m][k], acc[ai][bj][m][n], 0, 0, 0); \
    __builtin_amdgcn_s_setprio(0); } while (0)
#define WAIT_V(n) asm volatile("s_waitcnt vmcnt(" #n ")" ::: "memory")
#define WAIT_L(n) asm volatile("s_waitcnt lgkmcnt(" #n ")" ::: "memory")
#define BAR __builtin_amdgcn_s_barrier()
#define SCHED __builtin_amdgcn_sched_barrier(0)
  const int nM = M / BM, nN = N / BM, nwg = nM * nN;
  const int wid = threadIdx.x >> 6, lane = threadIdx.x & 63, wr = wid >> 2, wc = wid & 3, fr = lane & 15, fq = lane >> 4;
  const int nt = K / BK;
  unsigned soff0;
  { int _r, _c; stage_rc(threadIdx.x * 16, _r, _c); soff0 = (unsigned)(_r * K + _c); }
  const int aoff = lds_byte(wr * 64 + fr, fq * 8), boff = lds_byte(wc * 32 + fr, fq * 8);
  for (int Lw = blockIdx.x; Lw < nwg; Lw += gridDim.x) {
    int wgid = Lw;
    { int q = nwg / NXCD, r = nwg % NXCD, xcd = wgid % NXCD, off = wgid / NXCD; wgid = (xcd < r ? xcd * (q + 1) : r * (q + 1) + (xcd - r) * q) + off; }
    int nig = WGM * nN, gid = wgid / nig, fm = gid * WGM, gsz = min(nM - fm, WGM);
    int pm = fm + ((wgid % nig) % gsz), pn = (wgid % nig) / gsz, brow = pm * BM, bcol = pn * BM;
    f32x4 acc[2][2][4][2] = {};
    bf16x8 At[4][2], B0[2][2], B1[2][2];
    STAGE(SB(0, 0), Bt, bcol, 0); STAGE(SA(0, 0), A, brow, 0);
    STAGE(SB(0, 1), Bt, bcol + HALF, 0); STAGE(SA(0, 1), A, brow + HALF, 0);
    if (wr == 1) BAR;
    WAIT_V(4); BAR;
    STAGE(SB(1, 0), Bt, bcol, 1); STAGE(SA(1, 0), A, brow, 1); STAGE(SB(1, 1), Bt, bcol + HALF, 1);
    WAIT_V(6); BAR;
    for (int t = 0; t < nt - 2; t += 2) {
      LDB(B0, 0, 0); SCHED; LDA(At, 0, 0); STAGE(SA(1, 1), A, brow + HALF, t + 1);
      WAIT_L(8); BAR; WAIT_L(0); MMA(0, 0, At, B0); BAR; SCHED;
      LDB(B1, 0, 1); STAGE(SB(0, 0), Bt, bcol, t + 2);
      BAR; WAIT_L(0); MMA(0, 1, At, B1); BAR;
      LDA(At, 0, 1); STAGE(SA(0, 0), A, brow, t + 2);
      BAR; WAIT_L(0); MMA(1, 0, At, B0); BAR; SCHED;
      STAGE(SB(0, 1), Bt, bcol + HALF, t + 2);
      WAIT_V(6); BAR; MMA(1, 1, At, B1); BAR;
      LDB(B0, 1, 0); SCHED; LDA(At, 1, 0); STAGE(SA(0, 1), A, brow + HALF, t + 2);
      WAIT_L(8); BAR; WAIT_L(0); MMA(0, 0, At, B0); BAR; SCHED;
      LDB(B1, 1, 1); STAGE(SB(1, 0), Bt, bcol, t + 3);
      BAR; WAIT_L(0); MMA(0, 1, At, B1); BAR;
      LDA(At, 1, 1); STAGE(SA(1, 0), A, brow, t + 3);
      BAR; WAIT_L(0); MMA(1, 0, At, B0); BAR; SCHED;
      STAGE(SB(1, 1), Bt, bcol + HALF, t + 3);
      WAIT_V(6); BAR; MMA(1, 1, At, B1); BAR;
    }
    { LDB(B0, 0, 0); LDA(At, 0, 0); STAGE(SA(1, 1), A, brow + HALF, nt - 1);
      BAR; WAIT_L(0); MMA(0, 0, At, B0); BAR;
      LDB(B1, 0, 1); BAR; WAIT_L(0); MMA(0, 1, At, B1); BAR;
      LDA(At, 0, 1); WAIT_V(4); BAR; WAIT_L(0); MMA(1, 0, At, B0); MMA(1, 1, At, B1); BAR; }
    { LDB(B0, 1, 0); LDA(At, 1, 0); WAIT_V(2); BAR; WAIT_L(0); MMA(0, 0, At, B0); BAR;
      LDB(B1, 1, 1); WAIT_V(0); BAR; WAIT_L(0); MMA(0, 1, At, B1); BAR;
      LDA(At, 1, 1); BAR; WAIT_L(0); MMA(1, 0, At, B0); MMA(1, 1, At, B1); BAR; }
    if (wr == 0) BAR;
#pragma unroll
    for (int ai = 0; ai < 2; ++ai)
#pragma unroll
      for (int m = 0; m < 4; ++m)
#pragma unroll
        for (int bj = 0; bj < 2; ++bj)
          epi(acc[ai][bj][m][0], acc[ai][bj][m][1], brow + ai * HALF + wr * 64 + m * 16 + fr, bcol + bj * HALF + wc * 32 + fq * 8);
    __syncthreads();
  }
#undef SA
#undef SB
#undef STAGE
#undef LDA
#undef LDB
#undef MMA
}

struct EpiU {
  bf16_t* U; int ldu; int nvalid; const float* LB; int act;
  DEVI void operator()(const f32x4& a0, const f32x4& a1, int row, int col) const {
    if (col < nvalid) {
      float v[8] = {a0[0], a0[1], a0[2], a0[3], a1[0], a1[1], a1[2], a1[3]};
      if (act) {
        if (col < 512) {
#pragma unroll
          for (int i = 0; i < 8; ++i) v[i] = silu(v[i]);
        } else if (col >= 1024 && col < 2048) {
          const float4 l0 = *(const float4*)(LB + (col - 1024)), l1 = *(const float4*)(LB + (col - 1024) + 4);
          const float lb[8] = {l0.x, l0.y, l0.z, l0.w, l1.x, l1.y, l1.z, l1.w};
#pragma unroll
          for (int i = 0; i < 8; ++i) v[i] = (1.f - lb[i]) * sigm(-v[i]);
        } else if (col >= 2560 && col < 2816) {
#pragma unroll
          for (int i = 0; i < 8; ++i) v[i] *= 0.125f;
        }
      }
      *(uint4*)(U + (size_t)row * ldu + col) = make_uint4(pack2(v[0], v[1]), pack2(v[2], v[3]), pack2(v[4], v[5]), pack2(v[6], v[7]));
    }
  }
};
struct EpiRes {
  const float* xp; const float* xs; float* out; const float* mod;
  DEVI void operator()(const f32x4& a, int row, int col) const {
    const float* xr = row < NPT ? xp + (size_t)row * D : xs + (size_t)(row - NPT) * D;
    float4 x = *(const float4*)(xr + col);
    float4 g = *(const float4*)(mod + tok_seq(row) * 3072 + 2048 + col);
    float4 o;
    o.x = ALPHA * x.x + (1.f + g.x) * a[0]; o.y = ALPHA * x.y + (1.f + g.y) * a[1];
    o.z = ALPHA * x.z + (1.f + g.z) * a[2]; o.w = ALPHA * x.w + (1.f + g.w) * a[3];
    *(float4*)(out + (size_t)row * D + col) = o;
  }
};

DEVI void phase_prep(const P& p, char* smem) {
  const int tid = threadIdx.x;
  unsigned char* ws = p.ws;
  if (blockIdx.x == 0) {
    if (tid < 64) ((unsigned*)(ws + OFF_CNT))[tid] = 0u;
    float* LB = (float*)(ws + OFF_LB);
    for (int i = tid; i < 1024; i += NTHR) { int dir = i >> 9, d = i & 511; float l0 = p.lb_logits[dir * 1024 + d], l1 = p.lb_logits[dir * 1024 + 512 + d]; LB[i] = 1.f / (1.f + __expf(l1 - l0)); }
  }
  {
    float2* R = (float2*)(ws + OFF_ROPE);
    for (int i = blockIdx.x * NTHR + tid; i < 16384 * 32; i += gridDim.x * NTHR) {
      int pos = i >> 5, j = i & 31;
      float inv = (float)exp(-(double)j * (9.210340371976184 / 32.0));
      float ang = (float)pos * inv;
      float sn, cs; sincosf(ang, &sn, &cs);
      R[i] = make_float2(cs, sn);
    }
  }
  constexpr int NJ_MOD = 48, T_IN0 = 16 * (EV_PAD / 64), T_IN1 = 16 * (OD_PAD / 64), T_OUT = 256, NJ = NJ_MOD + T_IN0 + T_IN1 + 2 * T_OUT;
  for (int job = blockIdx.x; job < NJ; job += gridDim.x) {
    if (job < NJ_MOD) {
      const int layer = job / 24, cgp = job % 24;
      const float* wm = layer ? p.od_w_mod : p.ev_w_mod; const float* bm = layer ? p.od_b_mod : p.ev_b_mod;
      float* SC = (float*)smem;
      float* RED = SC + NSEQ * 1024;
      for (int i = tid; i < NSEQ * 1024; i += NTHR) { int s_ = i >> 10, d = i & 1023; float c = s_ < 2 ? p.c_prompt[s_ * 1024 + d] : p.c_sample[(s_ - 2) * 1024 + d]; SC[i] = silu(c); }
      __syncthreads();
      const int oc = tid & 127, o = cgp * 128 + oc, dq = tid >> 7;
      float acc[NSEQ];
#pragma unroll
      for (int s_ = 0; s_ < NSEQ; ++s_) acc[s_] = 0.f;
#pragma unroll 8
      for (int d = dq * 256; d < dq * 256 + 256; ++d) {
        float wv = wm[(size_t)d * 3072 + o];
#pragma unroll
        for (int s_ = 0; s_ < NSEQ; ++s_) acc[s_] += SC[s_ * 1024 + d] * wv;
      }
#pragma unroll
      for (int s_ = 0; s_ < NSEQ; ++s_) RED[(dq * NSEQ + s_) * 128 + oc] = acc[s_];
      __syncthreads();
      float* MOD = (float*)(ws + OFF_MOD);
      for (int i = tid; i < NSEQ * 128; i += NTHR) {
        int s_ = i >> 7, c_ = i & 127;
        float v = RED[(0 * NSEQ + s_) * 128 + c_] + RED[(1 * NSEQ + s_) * 128 + c_] + RED[(2 * NSEQ + s_) * 128 + c_] + RED[(3 * NSEQ + s_) * 128 + c_];
        MOD[(size_t)(layer * NSEQ + s_) * 3072 + cgp * 128 + c_] = v + bm[cgp * 128 + c_];
      }
      __syncthreads();
    } else {
      int j = job - NJ_MOD; const float* W; bf16_t* dst; int N, Npad;
      if (j < T_IN0) { W = p.ev_w_in; dst = (bf16_t*)(ws + OFF_WIN0); N = EV_IN; Npad = EV_PAD; }
      else if ((j -= T_IN0) < T_IN1) { W = p.od_w_in; dst = (bf16_t*)(ws + OFF_WIN1); N = OD_IN; Npad = OD_PAD; }
      else if ((j -= T_IN1) < T_OUT) { W = p.ev_w_out; dst = (bf16_t*)(ws + OFF_WOUT0); N = 1024; Npad = 1024; }
      else { j -= T_OUT; W = p.od_w_out; dst = (bf16_t*)(ws + OFF_WOUT1); N = 1024; Npad = 1024; }
      const int ntn = Npad / 64, kt = j / ntn, ntile = j % ntn;
      float* T = (float*)smem;
      for (int i = tid; i < 4096; i += NTHR) { int kk = i >> 6, nn = i & 63; int n = ntile * 64 + nn; T[kk * 65 + nn] = n < N ? W[(size_t)(kt * 64 + kk) * N + n] : 0.f; }
      __syncthreads();
      for (int i = tid; i < 4096; i += NTHR) { int nn = i >> 6, kk = i & 63; { const int q = nn & 31, rho = (((q >> 2) & 1) << 4) | ((q >> 3) << 2) | (q & 3); dst[(size_t)(ntile * 64 + (nn & 32) + rho) * 1024 + kt * 64 + kk] = f2bf(T[kk * 65 + nn]); } }
      __syncthreads();
    }
  }
}

DEVI void phase_modulate0(const P& p) {
  const int lane = threadIdx.x & 63, gw = blockIdx.x * 8 + (threadIdx.x >> 6), nw = gridDim.x * 8;
  const float* MOD = (const float*)(p.ws + OFF_MOD);
  bf16_t* H = (bf16_t*)(p.ws + OFF_H);
  for (int row = gw; row < NTOK; row += nw) {
    const float* xr = row < NPT ? p.x_prompt + (size_t)row * D : p.x_sample + (size_t)(row - NPT) * D;
    const float* m = MOD + tok_seq(row) * 3072;
#pragma unroll
    for (int i = 0; i < 4; ++i) {
      int col = i * 256 + lane * 4;
      float4 x = *(const float4*)(xr + col), sh = *(const float4*)(m + col), sc = *(const float4*)(m + 1024 + col);
      uint2 o; o.x = pack2(x.x * (1.f + sc.x) + sh.x, x.y * (1.f + sc.y) + sh.y); o.y = pack2(x.z * (1.f + sc.z) + sh.z, x.w * (1.f + sc.w) + sh.w);
      *(uint2*)(H + (size_t)row * D + col) = o;
    }
  }
}

DEVI void phase_ln(const P& p, int layer) {
  const int lane = threadIdx.x & 63, gw = blockIdx.x * 8 + (threadIdx.x >> 6), nw = gridDim.x * 8;
  const float* MODL = (const float*)(p.ws + OFF_MOD) + (size_t)layer * NSEQ * 3072;
  const float* MOD1 = (const float*)(p.ws + OFF_MOD) + (size_t)NSEQ * 3072;
  bf16_t* H = (bf16_t*)(p.ws + OFF_H);
  const bf16_t* Y = (const bf16_t*)(p.ws + OFF_U);
  const float* lg = layer ? p.od_ln_g : p.ev_ln_g; const float* lb = layer ? p.od_ln_b : p.ev_ln_b;
  for (int row = gw; row < NTOK; row += nw) {
    float* xo = p.out + (size_t)row * D;
    const float* xr = layer ? xo : (row < NPT ? p.x_prompt + (size_t)row * D : p.x_sample + (size_t)(row - NPT) * D);
    const int sq = tok_seq(row);
    const float* mg = MODL + sq * 3072 + 2048;
    float4 v[4]; float sm = 0.f;
#pragma unroll
    for (int i = 0; i < 4; ++i) {
      const int col = i * 256 + lane * 4;
      const float4 x = *(const float4*)(xr + col), g = *(const float4*)(mg + col);
      const uint2 yv = *(const uint2*)(Y + (size_t)row * D + col);
      v[i].x = ALPHA * x.x + (1.f + g.x) * __uint_as_float(yv.x << 16); v[i].y = ALPHA * x.y + (1.f + g.y) * __uint_as_float(yv.x & 0xffff0000u);
      v[i].z = ALPHA * x.z + (1.f + g.z) * __uint_as_float(yv.y << 16); v[i].w = ALPHA * x.w + (1.f + g.w) * __uint_as_float(yv.y & 0xffff0000u);
      sm += v[i].x + v[i].y + v[i].z + v[i].w;
    }
    const float mu = wave_sum(sm) * (1.f / 1024.f);
    float sq2 = 0.f;
#pragma unroll
    for (int i = 0; i < 4; ++i) { float a = v[i].x - mu, b = v[i].y - mu, c = v[i].z - mu, d = v[i].w - mu; sq2 += a * a + b * b + c * c + d * d; }
    const float rs = rsqrtf(wave_sum(sq2) * (1.f / 1024.f) + 1e-5f);
    const float* m = MOD1 + sq * 3072;
#pragma unroll
    for (int i = 0; i < 4; ++i) {
      int col = i * 256 + lane * 4;
      float4 g = *(const float4*)(lg + col), b = *(const float4*)(lb + col), y;
      y.x = (v[i].x - mu) * rs * g.x + b.x; y.y = (v[i].y - mu) * rs * g.y + b.y; y.z = (v[i].z - mu) * rs * g.z + b.z; y.w = (v[i].w - mu) * rs * g.w + b.w;
      *(float4*)(xo + col) = y;
      if (layer == 0) {
        float4 sh = *(const float4*)(m + col), sc = *(const float4*)(m + 1024 + col);
        uint2 o; o.x = pack2(y.x * (1.f + sc.x) + sh.x, y.y * (1.f + sc.y) + sh.y); o.y = pack2(y.z * (1.f + sc.z) + sh.z, y.w * (1.f + sc.w) + sh.w);
        *(uint2*)(H + (size_t)row * D + col) = o;
      }
    }
  }
}

DEVI void unpack8(const uint4& a, float* o) {
  o[0] = __uint_as_float(a.x << 16); o[1] = __uint_as_float(a.x & 0xffff0000u); o[2] = __uint_as_float(a.y << 16); o[3] = __uint_as_float(a.y & 0xffff0000u);
  o[4] = __uint_as_float(a.z << 16); o[5] = __uint_as_float(a.z & 0xffff0000u); o[6] = __uint_as_float(a.w << 16); o[7] = __uint_as_float(a.w & 0xffff0000u);
}

DEVI void phase_combine0(const P& p) {
  const int lane = threadIdx.x & 63, gw = blockIdx.x * 8 + (threadIdx.x >> 6), nw = gridDim.x * 8;
  bf16_t* H = (bf16_t*)(p.ws + OFF_H);
  const bf16_t* OB = (const bf16_t*)p.out;
  const bf16_t* U = (const bf16_t*)(p.ws + OFF_U);
  const int c0 = lane * 16;
  const float* nw_ = c0 < 512 ? p.hgrn_norm + c0 : p.gla_norm + (c0 - 512);
  const int gcol = c0 < 512 ? 2048 + c0 : 3616 + (c0 - 512);
  float wn[16];
#pragma unroll
  for (int i = 0; i < 16; ++i) wn[i] = nw_[i];
  for (int row = gw; row < NTOK; row += nw) {
    float a[16], b[16], g[16];
    unpack8(*(const uint4*)(H + (size_t)row * D + c0), a); unpack8(*(const uint4*)(H + (size_t)row * D + c0 + 8), a + 8);
    unpack8(*(const uint4*)(OB + (size_t)row * D + c0), b); unpack8(*(const uint4*)(OB + (size_t)row * D + c0 + 8), b + 8);
    unpack8(*(const uint4*)(U + (size_t)row * EV_IN + gcol), g); unpack8(*(const uint4*)(U + (size_t)row * EV_IN + gcol + 8), g + 8);
    float ss = 0.f;
#pragma unroll
    for (int i = 0; i < 16; ++i) { a[i] += b[i]; ss += a[i] * a[i]; }
    ss += __shfl_xor(ss, 1); ss += __shfl_xor(ss, 2); ss += __shfl_xor(ss, 4);
    const float rs = rsqrtf(ss * (1.f / 128.f) + 1e-6f);
    uint4 o0, o1;
    float r[16];
#pragma unroll
    for (int i = 0; i < 16; ++i) r[i] = a[i] * rs * wn[i] * silu(g[i]);
    o0.x = pack2(r[0], r[1]); o0.y = pack2(r[2], r[3]); o0.z = pack2(r[4], r[5]); o0.w = pack2(r[6], r[7]);
    o1.x = pack2(r[8], r[9]); o1.y = pack2(r[10], r[11]); o1.z = pack2(r[12], r[13]); o1.w = pack2(r[14], r[15]);
    *(uint4*)(H + (size_t)row * D + c0) = o0; *(uint4*)(H + (size_t)row * D + c0 + 8) = o1;
  }
}

DEVI void phase_rwkv_post(const P& p) {
  const int lane = threadIdx.x & 63, gw = blockIdx.x * 8 + (threadIdx.x >> 6), nw = gridDim.x * 8;
  bf16_t* H = (bf16_t*)(p.ws + OFF_H);
  const bf16_t* OB = (const bf16_t*)(p.ws + OFF_OB1);
  const bf16_t* U = (const bf16_t*)(p.ws + OFF_U);
  const float* BON = (const float*)(p.ws + OFF_BONUS);
  const int c0 = lane * 8, hd_ = lane >> 3;
  float lw[8], lb[8], mv0[8], mv1[8], mg0[8], mg1[8];
#pragma unroll
  for (int i = 0; i < 8; ++i) {
    lw[i] = p.rwkv_ln_w[c0 + i]; lb[i] = p.rwkv_ln_b[c0 + i];
    mv0[i] = p.rwkv_mix[1024 + c0 + i]; mv1[i] = p.rwkv_mix[2144 + 1024 + c0 + i];
    mg0[i] = p.rwkv_mix[1632 + c0 + i]; mg1[i] = p.rwkv_mix[2144 + 1632 + c0 + i];
  }
  for (int row = gw; row < NTOK; row += nw) {
    int s = tok_seq(row), L, tb; seq_info(s, L, tb);
    const int pos = row - tb;
    float a[8], b[8], v[8], vp[8], vn[8], g[8], gp[8], gn[8];
    unpack8(*(const uint4*)(H + (size_t)row * D + 512 + c0), a);
    unpack8(*(const uint4*)(OB + (size_t)row * 512 + c0), b);
    const bf16_t* ur = U + (size_t)row * OD_IN;
    unpack8(*(const uint4*)(ur + 2304 + c0), v); unpack8(*(const uint4*)(ur + 2912 + c0), g);
    if (pos > 0) { unpack8(*(const uint4*)(ur - OD_IN + 2304 + c0), vp); unpack8(*(const uint4*)(ur - OD_IN + 2912 + c0), gp); }
    else {
#pragma unroll
      for (int i = 0; i < 8; ++i) { vp[i] = 0.f; gp[i] = 0.f; }
    }
    if (pos < L - 1) { unpack8(*(const uint4*)(ur + OD_IN + 2304 + c0), vn); unpack8(*(const uint4*)(ur + OD_IN + 2912 + c0), gn); }
    else {
#pragma unroll
      for (int i = 0; i < 8; ++i) { vn[i] = 0.f; gn[i] = 0.f; }
    }
    float sm = 0.f;
#pragma unroll
    for (int i = 0; i < 8; ++i) { a[i] += b[i]; sm += a[i]; }
    sm += __shfl_xor(sm, 1); sm += __shfl_xor(sm, 2); sm += __shfl_xor(sm, 4);
    const float mu = sm * (1.f / 64.f);
    float sq = 0.f;
#pragma unroll
    for (int i = 0; i < 8; ++i) { float d = a[i] - mu; sq += d * d; }
    sq += __shfl_xor(sq, 1); sq += __shfl_xor(sq, 2); sq += __shfl_xor(sq, 4);
    const float rs = rsqrtf(sq * (1.f / 64.f) + 64e-5f);
    const float bon = BON[(size_t)row * 8 + hd_];
    float r[8];
#pragma unroll
    for (int i = 0; i < 8; ++i) {
      float zv = v[i] + mv0[i] * (vp[i] - v[i]) + mv1[i] * (vn[i] - v[i]);
      float zg = g[i] + mg0[i] * (gp[i] - g[i]) + mg1[i] * (gn[i] - g[i]);
      r[i] = ((a[i] - mu) * rs * lw[i] + lb[i] + bon * zv) * silu(zg);
    }
    uint4 o; o.x = pack2(r[0], r[1]); o.y = pack2(r[2], r[3]); o.z = pack2(r[4], r[5]); o.w = pack2(r[6], r[7]);
    *(uint4*)(H + (size_t)row * D + 512 + c0) = o;
  }
}
#define MFMA16(a, b, c) __builtin_amdgcn_mfma_f32_16x16x32_bf16(a, b, c, 0, 0, 0)
template <int K, int MIX, int MODE>
DEVI void scan0_task(const P& p, char* smem, int s, int h, int dir, int n0, int nc, int sbase, int g) {
  constexpr int TQ = 512 / K, TS = 64 / TQ, KS = K + 8, NKT = K / 16, NKS = K / 32;
  bf16_t* QD = (bf16_t*)smem;
  bf16_t* KI = QD + 64 * KS;
  bf16_t* KET = KI + 64 * KS;
  bf16_t* VT = KET + K * 72;
  bf16_t* ATT = VT + 128 * 72;
  bf16_t* ST = ATT + 64 * 72;
  float* PART = (float*)(ST + 128 * KS);
  float* DEC = PART + TQ * K;
  const int tid = threadIdx.x, lane = tid & 63, w = tid >> 6, fr = lane & 15, fq = lane >> 4;
  int L, tb; seq_info(s, L, tb);
  const bf16_t* U = (const bf16_t*)(p.ws + OFF_U);
  bf16_t* OUT = dir ? (bf16_t*)p.out : (bf16_t*)(p.ws + OFF_H);
  const int ocol = MIX * 512 + h * 128;
  const int k = tid % K, tq = tid / K;
  const int vc2 = tid & 63, vq8 = tid >> 6;
  const int vbase = MIX == 0 ? 512 + h * 128 : 3072 + h * 128;
  float lbv = 0.f, bgk = 0.f; float wg[16];
  if (MIX == 0) { lbv = ((const float*)(p.ws + OFF_LB))[dir * 512 + h * 128 + k];
#pragma unroll
    for (int j = 0; j < 16; ++j) wg[j] = 0.f;
  } else {
#pragma unroll
    for (int j = 0; j < 16; ++j) wg[j] = p.gla_w_gk[(dir * 16 + j) * 256 + h * 64 + k];
    bgk = p.gla_b_gk[dir * 256 + h * 64 + k];
  }
  __syncthreads();
  f32x4 accS[NKT];
#pragma unroll
  for (int i = 0; i < NKT; ++i) accS[i] = (f32x4){0.f, 0.f, 0.f, 0.f};
  float dsum = 0.f;
  if (MODE == 0) {
    for (int j = 0; j < g; ++j) {
      const float* SL = (const float*)(p.ws + OFF_SLOC) + (size_t)(sbase + j) * 16384;
      const float* DT = (const float*)(p.ws + OFF_DTOT) + (size_t)(sbase + j) * 128;
#pragma unroll
      for (int tk = 0; tk < NKT; ++tk) {
        const float dcy = __expf(DT[tk * 16 + fr]);
#pragma unroll
        for (int e = 0; e < 4; ++e) accS[tk][e] = accS[tk][e] * dcy + SL[(w * 16 + fq * 4 + e) * 128 + tk * 16 + fr];
      }
    }
#pragma unroll
    for (int tk = 0; tk < NKT; ++tk)
#pragma unroll
      for (int e = 0; e < 4; ++e) ST[(w * 16 + fq * 4 + e) * KS + tk * 16 + fr] = f2bf(accS[tk][e]);
  }
  const int NE = n0 + nc;
  float* BLS = DEC + K;
  unsigned short rq[TS], rf[TS]; unsigned rv[8];
  uint4 rbl = make_uint4(0u, 0u, 0u, 0u);
  auto issue = [&](int n) {
#pragma unroll
    for (int i = 0; i < TS; ++i) {
      const int tt = n * 64 + tq * TS + i; const int pos = dir ? L - 1 - tt : tt;
      const bf16_t* row = U + (size_t)(tb + pos) * EV_IN;
      if (MIX == 0) { if (MODE == 0) rq[i] = row[h * 128 + k]; rf[i] = row[1024 + dir * 512 + h * 128 + k]; }
      else { if (MODE == 0) rq[i] = row[2560 + h * 64 + k]; rf[i] = row[2816 + h * 64 + k]; }
    }
#pragma unroll
    for (int i = 0; i < 8; ++i) {
      const int tt = n * 64 + vq8 * 8 + i; const int pos = dir ? L - 1 - tt : tt;
      rv[i] = *(const unsigned*)(U + (size_t)(tb + pos) * EV_IN + vbase + 2 * vc2);
    }
    if (MIX == 1 && tid < 128) {
      const int tt = n * 64 + (tid >> 1); const int pos = dir ? L - 1 - tt : tt;
      rbl = *(const uint4*)(U + (size_t)(tb + pos) * EV_IN + 3584 + dir * 16 + (tid & 1) * 8);
    }
  };
  issue(n0);
  for (int n = n0; n < NE; ++n) {
    float cb[TS];
    float run = 0.f;
    if (MIX == 1) {
      if (tid < 128) { float bv[8]; unpack8(rbl, bv); float* d = BLS + (tid >> 1) * 16 + (tid & 1) * 8;
#pragma unroll
        for (int j = 0; j < 8; ++j) d[j] = bv[j]; }
      __syncthreads();
    }
#pragma unroll
    for (int i = 0; i < TS; ++i) {
      float lf;
      if (MIX == 0) {
        lf = __logf(1.f - bf2f(rf[i]));
      } else {
        const float4* bl = (const float4*)(BLS + (tq * TS + i) * 16);
        float z = bgk;
#pragma unroll
        for (int j = 0; j < 4; ++j) { float4 b4 = bl[j]; z += b4.x * wg[4 * j] + b4.y * wg[4 * j + 1] + b4.z * wg[4 * j + 2] + b4.w * wg[4 * j + 3]; }
        lf = (fminf(z, 0.f) - __logf(1.f + __expf(-fabsf(z)))) * (1.f / 16.f);
      }
      run += lf; cb[i] = run;
    }
    PART[tq * K + k] = run;
    __syncthreads();
    {
      uint4 lo, hi;
      lo.x = (rv[0] & 0xffffu) | (rv[1] << 16); lo.y = (rv[2] & 0xffffu) | (rv[3] << 16); lo.z = (rv[4] & 0xffffu) | (rv[5] << 16); lo.w = (rv[6] & 0xffffu) | (rv[7] << 16);
      hi.x = (rv[0] >> 16) | (rv[1] & 0xffff0000u); hi.y = (rv[2] >> 16) | (rv[3] & 0xffff0000u); hi.z = (rv[4] >> 16) | (rv[5] & 0xffff0000u); hi.w = (rv[6] >> 16) | (rv[7] & 0xffff0000u);
      *(uint4*)(VT + (2 * vc2) * 72 + vq8 * 8) = lo; *(uint4*)(VT + (2 * vc2 + 1) * 72 + vq8 * 8) = hi;
    }
    float pre = 0.f, tot = 0.f;
#pragma unroll
    for (int j = 0; j < TQ; ++j) { float v = PART[j * K + k]; tot += v; if (j < tq) pre += v; }
    const float etot = __expf(tot);
    if (tq == 0) { DEC[k] = etot; dsum += tot; }
    {
      unsigned pk[TS / 2];
#pragma unroll
      for (int i = 0; i < TS; i += 2) {
        const int t0 = tq * TS + i;
        const float k0 = bf2f(rf[i]), k1 = bf2f(rf[i + 1]);
        const float e0 = __expf(pre + cb[i]), e1 = __expf(pre + cb[i + 1]);
        const float ki0 = k0 * frcp(e0), ki1 = k1 * frcp(e1);
        if (MODE == 0) {
          QD[t0 * KS + k] = f2bf(bf2f(rq[i]) * e0); QD[(t0 + 1) * KS + k] = f2bf(bf2f(rq[i + 1]) * e1);
          KI[t0 * KS + k] = f2bf(ki0); KI[(t0 + 1) * KS + k] = f2bf(ki1);
        }
        pk[i / 2] = pack2(ki0 * etot, ki1 * etot);
      }
      uint4* dst = (uint4*)(KET + k * 72 + tq * TS);
      dst[0] = make_uint4(pk[0], pk[1], pk[2], pk[3]);
      if (TS == 16) dst[1] = make_uint4(pk[TS / 2 - 4], pk[TS / 2 - 3], pk[TS / 2 - 2], pk[TS / 2 - 1]);
    }
    if (n + 1 < NE) issue(n + 1);
    __syncthreads();
    if (MODE == 0) {
      const int ti = w >> 1;
#pragma unroll
      for (int c2 = 0; c2 < 2; ++c2) {
        const int tj = (w & 1) * 2 + c2;
        f32x4 a = {0.f, 0.f, 0.f, 0.f};
        if (tj <= ti) {
#pragma unroll
          for (int ks = 0; ks < NKS; ++ks) {
            bf16x8 kf = *(const bf16x8*)(KI + (tj * 16 + fr) * KS + ks * 32 + fq * 8);
            bf16x8 qf = *(const bf16x8*)(QD + (ti * 16 + fr) * KS + ks * 32 + fq * 8);
            a = MFMA16(kf, qf, a);
          }
        }
        const int i = ti * 16 + fr, j0 = tj * 16 + fq * 4;
        uint2 v; v.x = pack2(j0 <= i ? a[0] : 0.f, j0 + 1 <= i ? a[1] : 0.f); v.y = pack2(j0 + 2 <= i ? a[2] : 0.f, j0 + 3 <= i ? a[3] : 0.f);
        *(uint2*)(ATT + i * 72 + j0) = v;
      }
    }
    if (MODE == 0) __syncthreads();
    {
      const int tv = w;
      bf16x8 vf[2], sf[NKS];
#pragma unroll
      for (int ks = 0; ks < 2; ++ks) vf[ks] = *(const bf16x8*)(VT + (tv * 16 + fr) * 72 + ks * 32 + fq * 8);
      if (MODE == 0) {
#pragma unroll
      for (int ks = 0; ks < NKS; ++ks) sf[ks] = *(const bf16x8*)(ST + (tv * 16 + fr) * KS + ks * 32 + fq * 8);
#pragma unroll
      for (int ti = 0; ti < 4; ++ti) {
        f32x4 o = {0.f, 0.f, 0.f, 0.f};
#pragma unroll
        for (int ks = 0; ks < 2; ++ks) { bf16x8 af = *(const bf16x8*)(ATT + (ti * 16 + fr) * 72 + ks * 32 + fq * 8); o = MFMA16(vf[ks], af, o); }
#pragma unroll
        for (int ks = 0; ks < NKS; ++ks) { bf16x8 qf = *(const bf16x8*)(QD + (ti * 16 + fr) * KS + ks * 32 + fq * 8); o = MFMA16(sf[ks], qf, o); }
        const int tt = n * 64 + ti * 16 + fr; const int pos = dir ? L - 1 - tt : tt;
        uint2 ov; ov.x = pack2(o[0], o[1]); ov.y = pack2(o[2], o[3]);
        *(uint2*)(OUT + (size_t)(tb + pos) * D + ocol + tv * 16 + fq * 4) = ov;
      }
      }
#pragma unroll
      for (int tk = 0; tk < NKT; ++tk) {
        const float dc = DEC[tk * 16 + fr];
        f32x4 a = accS[tk]; a[0] *= dc; a[1] *= dc; a[2] *= dc; a[3] *= dc;
#pragma unroll
        for (int ks = 0; ks < 2; ++ks) { bf16x8 kf = *(const bf16x8*)(KET + (tk * 16 + fr) * 72 + ks * 32 + fq * 8); a = MFMA16(vf[ks], kf, a); }
        accS[tk] = a;
      }
    }
    if (MODE == 0) {
      const int tv = w;
#pragma unroll
      for (int tk = 0; tk < NKT; ++tk)
#pragma unroll
        for (int e = 0; e < 4; ++e) ST[(tv * 16 + fq * 4 + e) * KS + tk * 16 + fr] = f2bf(accS[tk][e]);
    }
  }
  if (MODE == 1) {
    float* SL = (float*)(p.ws + OFF_SLOC) + (size_t)(sbase + g) * 16384;
#pragma unroll
    for (int tk = 0; tk < NKT; ++tk)
#pragma unroll
      for (int e = 0; e < 4; ++e) SL[(w * 16 + fq * 4 + e) * 128 + tk * 16 + fr] = accS[tk][e];
    if (tq == 0) ((float*)(p.ws + OFF_DTOT))[(size_t)(sbase + g) * 128 + k] = dsum;
  }
  __syncthreads();
}
template <int MODE, int DIR>
DEVI void rwkv_task(const P& p, char* smem, int s, int h, int n0, int nc, int sbase, int g) {
  constexpr int dir = DIR;
  bf16_t* QH = (bf16_t*)smem;
  bf16_t* RH = QH + 4 * 16 * 72;
  bf16_t* BT = RH + 4 * 16 * 72;
  bf16_t* KT = BT + 4 * 16 * 72;
  bf16_t* BKE = KT + 4 * 16 * 72;
  bf16_t* VB = BKE + 4 * 64 * 40;
  float* GT = (float*)(VB + 4 * 64 * 24);
  float* AU = GT + 4 * 64;
  bf16_t* NT = (bf16_t*)(AU + 4 * 256);
  float* OO = (float*)(NT + 4 * 256);
  float* SCAL = OO + 64 * 64;
  bf16_t* LOW = (bf16_t*)(SCAL + 256);
  const int tid = threadIdx.x, lane = tid & 63, w = tid >> 6, fr = lane & 15, fq = lane >> 4;
  int L, tb; seq_info(s, L, tb);
  const bf16_t* U = (const bf16_t*)(p.ws + OFF_U);
  const float* mix0 = p.rwkv_mix; const float* mix1 = p.rwkv_mix + 2144;
  const int hc0 = h * 64;
  const int tt = w >> 1;
  float* CT = (float*)(LOW + 64 * 72);
  bf16_t* W2T = (bf16_t*)(CT + 13 * 64);
  bf16_t* A2T = W2T + 64 * 40;
  __syncthreads();
  if (tid < 64) {
    const int c = hc0 + tid;
    CT[0 * 64 + tid] = p.rwkv_w0[dir * 512 + c]; CT[1 * 64 + tid] = p.rwkv_a0[c]; CT[2 * 64 + tid] = p.rwkv_k_k[c]; CT[3 * 64 + tid] = p.rwkv_k_a[c]; CT[4 * 64 + tid] = p.rwkv_r_k[c];
    { const int lcol_ = tid < 32 ? 2816 + dir * 32 + tid : 2880 + (tid - 32); CT[11 * 64 + tid] = mix0[lcol_ - 1280]; CT[12 * 64 + tid] = mix1[lcol_ - 1280]; }
    CT[5 * 64 + tid] = mix0[c]; CT[6 * 64 + tid] = mix1[c]; CT[7 * 64 + tid] = mix0[512 + c]; CT[8 * 64 + tid] = mix1[512 + c]; CT[9 * 64 + tid] = mix0[1024 + c]; CT[10 * 64 + tid] = mix1[1024 + c];
  }
  for (int i = tid; i < 64 * 32; i += NTHR) {
    const int j = i >> 6, c = i & 63;
    W2T[c * 40 + j] = f2bf(p.rwkv_w_w2[(size_t)(dir * 32 + j) * 512 + hc0 + c]);
    A2T[c * 40 + j] = f2bf(p.rwkv_a_w2[(size_t)j * 512 + hc0 + c]);
  }
  const int lc = tid & 63, tg = tid >> 6;
  f32x4 accS[4];
#pragma unroll
  for (int i = 0; i < 4; ++i) accS[i] = (f32x4){0.f, 0.f, 0.f, 0.f};
  const int wl = w & 3;
  if (MODE == 1 && w >= 4) {
#pragma unroll
    for (int tk = 0; tk < 4; ++tk)
#pragma unroll
      for (int e = 0; e < 4; ++e) accS[tk][e] = (tk * 16 + fq * 4 + e == wl * 16 + fr) ? 1.f : 0.f;
  }
  bf16_t* OUTB = dir ? (bf16_t*)(p.ws + OFF_OB1) : (bf16_t*)(p.ws + OFF_H);
  const int ostride = dir ? 512 : 1024, ocol = dir ? hc0 : 512 + hc0;
  float* BON = (float*)(p.ws + OFF_BONUS);
  const int NC = L / 64;
  bf16_t* RAW = A2T + 64 * 40;
  uint4 pre[5];
  auto issue = [&](int n) {
    const int Pb = dir ? L - 64 * (n + 1) : 64 * n;
    const bf16_t* ub = U + (size_t)(tb + Pb) * OD_IN;
#pragma unroll
    for (int j = 0; j < 5; ++j) {
      const int ui = threadIdx.x + j * NTHR, row = ui >> 5, sg = ui & 31;
      const int col = sg < 8 ? 1280 + hc0 + sg * 8 : sg < 16 ? 1792 + hc0 + (sg - 8) * 8 : sg < 24 ? 2304 + hc0 + (sg - 16) * 8 : sg < 28 ? 2816 + dir * 32 + (sg - 24) * 8 : 2880 + (sg - 28) * 8;
      const int pa = Pb + row - 1;
      pre[j] = make_uint4(0u, 0u, 0u, 0u);
      if (row < 66 && pa >= 0 && pa < L) pre[j] = *(const uint4*)(ub + (row - 1) * OD_IN + col);
    }
  };
  if (MODE == 0 && g > 0) {
    float* Sb = OO; float* Mb = (float*)RAW;
    const float* NM = (const float*)(p.ws + OFF_SLOC);
    const int fv = tid >> 3, fk = (tid & 7) * 8;
    __syncthreads();
    { const float* N0 = NM + (size_t)sbase * 8192 + fv * 64 + fk; *(float4*)(Sb + fv * 64 + fk) = *(const float4*)N0; *(float4*)(Sb + fv * 64 + fk + 4) = *(const float4*)(N0 + 4); }
    for (int j = 1; j < g; ++j) {
      const float* Nj = NM + (size_t)(sbase + j) * 8192; const float* Mj = Nj + 4096;
      *(float4*)(Mb + fv * 64 + fk) = *(const float4*)(Mj + fv * 64 + fk); *(float4*)(Mb + fv * 64 + fk + 4) = *(const float4*)(Mj + fv * 64 + fk + 4);
      float acc[8];
      { const float4 a0 = *(const float4*)(Nj + fv * 64 + fk), a1 = *(const float4*)(Nj + fv * 64 + fk + 4); acc[0] = a0.x; acc[1] = a0.y; acc[2] = a0.z; acc[3] = a0.w; acc[4] = a1.x; acc[5] = a1.y; acc[6] = a1.z; acc[7] = a1.w; }
      __syncthreads();
      for (int kp = 0; kp < 64; ++kp) {
        const float sv = Sb[fv * 64 + kp];
        const float4 m0 = *(const float4*)(Mb + kp * 64 + fk), m1 = *(const float4*)(Mb + kp * 64 + fk + 4);
        acc[0] += sv * m0.x; acc[1] += sv * m0.y; acc[2] += sv * m0.z; acc[3] += sv * m0.w; acc[4] += sv * m1.x; acc[5] += sv * m1.y; acc[6] += sv * m1.z; acc[7] += sv * m1.w;
      }
      __syncthreads();
      *(float4*)(Sb + fv * 64 + fk) = make_float4(acc[0], acc[1], acc[2], acc[3]); *(float4*)(Sb + fv * 64 + fk + 4) = make_float4(acc[4], acc[5], acc[6], acc[7]);
    }
    __syncthreads();
    if (w < 4) {
#pragma unroll
      for (int tk = 0; tk < 4; ++tk) { const float4 t4 = *(const float4*)(Sb + (w * 16 + fr) * 64 + tk * 16 + fq * 4); accS[tk][0] = t4.x; accS[tk][1] = t4.y; accS[tk][2] = t4.z; accS[tk][3] = t4.w; }
    }
    __syncthreads();
  }
  const int NE = n0 + nc;
  issue(n0);
  if (tid < 256) SCAL[tid] = 0.f;
  __syncthreads();
  for (int n = n0; n < NE; ++n) {
    const int Pbase = dir ? L - 64 * (n + 1) : 64 * n;
    int tid; asm volatile("v_mov_b32 %0, %1" : "=v"(tid) : "v"(threadIdx.x));
    const int lane = tid & 63, w = tid >> 6, fr = lane & 15, fq = lane >> 4, tt = w >> 1, lc = tid & 63, tg = tid >> 6, wl = w & 3;
#pragma unroll
    for (int j = 0; j < 5; ++j) { const int ui = tid + j * NTHR; if (ui < 66 * 32) *(uint4*)(RAW + (ui >> 5) * 264 + (ui & 31) * 8) = pre[j]; }
    __syncthreads();
    {
      float u[10];
      const float lm0 = CT[11 * 64 + lc], lm1 = CT[12 * 64 + lc];
#pragma unroll
      for (int i = 0; i < 10; ++i) u[i] = bf2f(RAW[(tg * 8 + i) * 264 + 192 + lc]);
#pragma unroll
      for (int i = 0; i < 8; ++i) {
        float z = u[i + 1] + lm0 * (u[i] - u[i + 1]) + lm1 * (u[i + 2] - u[i + 1]);
        if (lc < 32) z = ftanh(z);
        const int pc = tg * 8 + i, t = dir ? 63 - pc : pc;
        LOW[t * 72 + lc] = f2bf(z);
      }
    }
    const int tl = tt * 16 + fq * 4;
    const int pcl = dir ? 63 - (tl + 3) : tl;
    {
      float nsq[4] = {0.f, 0.f, 0.f, 0.f};
#pragma unroll
      for (int c2 = 0; c2 < 2; ++c2) {
        const int cl_ = ((w & 1) * 2 + c2) * 16 + fr;
        const float kkc_ = CT[128 + cl_], m0k_ = CT[448 + cl_], m1k_ = CT[512 + cl_];
        float uk[6];
#pragma unroll
        for (int i = 0; i < 6; ++i) uk[i] = bf2f(RAW[(pcl + i) * 264 + 64 + cl_]);
#pragma unroll
        for (int e = 0; e < 4; ++e) {
          const float ukc = dir ? uk[4 - e] : uk[1 + e], ukm = dir ? uk[3 - e] : uk[e], ukp = dir ? uk[5 - e] : uk[2 + e];
          const float kkraw = (ukc + m0k_ * (ukm - ukc) + m1k_ * (ukp - ukc)) * kkc_;
          nsq[e] += kkraw * kkraw;
        }
      }
      reduce4_row16(nsq[0], nsq[1], nsq[2], nsq[3]);
      if (fr == 0) {
#pragma unroll
        for (int e = 0; e < 4; ++e) atomicAdd(&SCAL[(tl + e) * 4 + 0], nsq[e]);
      }
    }
    __syncthreads();
    {
      const bf16x8 aW = *(const bf16x8*)(LOW + (tt * 16 + fr) * 72 + fq * 8);
      const bf16x8 aA = *(const bf16x8*)(LOW + (tt * 16 + fr) * 72 + 32 + fq * 8);
      float sbo[4] = {0.f, 0.f, 0.f, 0.f};
      float inv4[4];
#pragma unroll
      for (int e = 0; e < 4; ++e) inv4[e] = rsqrtf(fmaxf(SCAL[(tl + e) * 4], 1e-24f));
#pragma unroll
      for (int c2 = 0; c2 < 2; ++c2) {
        f32x4 z4 = {0.f, 0.f, 0.f, 0.f};
        const int cl = ((w & 1) * 2 + c2) * 16 + fr;
        f32x4 wd = MFMA16(aW, *(const bf16x8*)(W2T + cl * 40 + fq * 8), z4);
        f32x4 ad = MFMA16(aA, *(const bf16x8*)(A2T + cl * 40 + fq * 8), z4);
        float ur[6], uk[6], uv[6];
        const float w0c_ = CT[cl], a0c_ = CT[64 + cl], kkc_ = CT[128 + cl], kac_ = CT[192 + cl], rkc_ = CT[256 + cl];
        const float m0r_ = CT[320 + cl], m1r_ = CT[384 + cl], m0k_ = CT[448 + cl], m1k_ = CT[512 + cl], m0v_ = CT[576 + cl], m1v_ = CT[640 + cl];
#pragma unroll
        for (int i = 0; i < 6; ++i) { const bf16_t* rr = RAW + (pcl + i) * 264 + cl; ur[i] = bf2f(rr[0]); uk[i] = bf2f(rr[64]); uv[i] = bf2f(rr[128]); }
        float zr[4], wdc[4], kmv[4], zv4[4], kk4[4], b4[4];
#pragma unroll
        for (int e = 0; e < 4; ++e) {
          const float urc = dir ? ur[4 - e] : ur[1 + e], urm = dir ? ur[3 - e] : ur[e], urp = dir ? ur[5 - e] : ur[2 + e];
          const float ukc = dir ? uk[4 - e] : uk[1 + e], ukm = dir ? uk[3 - e] : uk[e], ukp = dir ? uk[5 - e] : uk[2 + e];
          const float uvc = dir ? uv[4 - e] : uv[1 + e], uvm = dir ? uv[3 - e] : uv[e], uvp = dir ? uv[5 - e] : uv[2 + e];
          const float r_ = urc + m0r_ * (urm - urc) + m1r_ * (urp - urc);
          const float k_ = ukc + m0k_ * (ukm - ukc) + m1k_ * (ukp - ukc);
          const float v_ = uvc + m0v_ * (uvm - uvc) + m1v_ * (uvp - uvc);
          const float a_ = sigm(a0c_ + ad[e]);
          zr[e] = r_; wdc[e] = __expf(-0.6065306597126334f * sigm(w0c_ + wd[e])); kmv[e] = k_ * (1.f + (a_ - 1.f) * kac_); zv4[e] = v_;
          kk4[e] = k_ * kkc_ * inv4[e]; b4[e] = kk4[e] * a_;
          sbo[e] += r_ * kmv[e] * rkc_;
        }
        float pr[4];
        pr[0] = wdc[0]; pr[1] = pr[0] * wdc[1]; pr[2] = pr[1] * wdc[2]; pr[3] = pr[2] * wdc[3];
        const float x = pr[3];
        float y = __shfl_up(x, 16); y = fq >= 1 ? x * y : x;
        float z = __shfl_up(y, 32); z = fq >= 2 ? y * z : y;
        float ex = __shfl_up(z, 16); ex = fq >= 1 ? ex : 1.f;
        const float gtot = __shfl(z, 48 + fr);
        float be[4], ke[4];
#pragma unroll
        for (int e = 0; e < 4; ++e) {
          const float Gt = ex * pr[e], Gm = e ? ex * pr[e > 0 ? e - 1 : 0] : ex;
          const float ig = frcp(Gt);
          const int ro = (tt * 16 + fq * 4 + e) * 72 + cl;
          QH[ro] = f2bf(Gm * kk4[e]); RH[ro] = f2bf(Gt * zr[e]);
          const float btl = b4[e] * ig, ktl = kmv[e] * ig;
          BT[ro] = f2bf(btl); KT[ro] = f2bf(ktl);
          be[e] = btl * gtot; ke[e] = ktl * gtot;
        }
        *(uint4*)(BKE + (tt * 64 + cl) * 40 + fq * 8) = make_uint4(pack2(be[0], be[1]), pack2(be[2], be[3]), pack2(ke[0], ke[1]), pack2(ke[2], ke[3]));
        *(uint2*)(VB + (tt * 64 + cl) * 24 + fq * 4) = make_uint2(pack2(zv4[0], zv4[1]), pack2(zv4[2], zv4[3]));
        if (fq == 0) GT[tt * 64 + cl] = gtot;
      }
      reduce4_row16(sbo[0], sbo[1], sbo[2], sbo[3]);
      if (fr == 0) {
#pragma unroll
        for (int e = 0; e < 4; ++e) atomicAdd(&SCAL[(tl + e) * 4 + 3], sbo[e]);
      }
    }
    __syncthreads();
    if (MODE == 0 && dir == 0 && tid < 64) BON[(size_t)(tb + Pbase + tid) * 8 + h] = SCAL[tid * 4 + 3];
#ifndef NO_PD
    int oz; asm volatile("v_mov_b32 %0, 0" : "=v"(oz));
    if (w >= 4) {
      const int bt = w - 4;
      f32x4 au = {0.f, 0.f, 0.f, 0.f};
#pragma unroll
      for (int ks = 0; ks < 2; ++ks) {
        const bf16x8 af = *(const bf16x8*)(BT + (bt * 16 + fr) * 72 + ks * 32 + fq * 8);
        const bf16x8 qf = *(const bf16x8*)(QH + (bt * 16 + fr) * 72 + ks * 32 + fq * 8);
        au = MFMA16(af, qf, au);
      }
#pragma unroll
      for (int e = 0; e < 4; ++e) AU[(bt * 16 + fq * 4 + e) * 16 + fr] = au[e];
      asm volatile("s_waitcnt lgkmcnt(0)" ::: "memory");
      const int ii = (lane & 15) + oz;
      float Y[16];
#pragma unroll
      for (int j = 0; j < 16; ++j) Y[j] = (j == ii) ? 1.f : 0.f;
#pragma unroll
      for (int k = 0; k < 15; ++k) {
        const float4* rowp = (const float4*)(AU + (bt * 16 + k) * 16);
        float rv[16];
#pragma unroll
        for (int q = 0; q < 4; ++q) { if (q * 4 + 3 > k) { const float4 t4 = rowp[q]; rv[q * 4] = t4.x; rv[q * 4 + 1] = t4.y; rv[q * 4 + 2] = t4.z; rv[q * 4 + 3] = t4.w; } }
#pragma unroll
        for (int j = k + 1; j < 16; ++j) Y[j] -= rv[j] * Y[k];
        if ((k & 3) == 3) __builtin_amdgcn_sched_barrier(0);
      }
      if (fq == 0) {
#pragma unroll
        for (int j = 0; j < 16; ++j) NT[(bt * 16 + j) * 16 + ii] = f2bf(-Y[j]);
      }
    }
#endif
    __syncthreads();
    if (tid < 256) SCAL[tid] = 0.f;
    if (n + 1 < NE) issue(n + 1);
#ifndef NO_PE
    if (w < 4 || MODE == 1) {
#pragma unroll
      for (int bt = 0; bt < 4; ++bt) {
        const bf16_t* qh = QH + (bt * 16 + fr) * 72; const bf16_t* rh = RH + (bt * 16 + fr) * 72;
        const bf16_t* bth = BT + (bt * 16 + fr) * 72; const bf16_t* kth = KT + (bt * 16 + fr) * 72;
        f32x4 avk = {0.f, 0.f, 0.f, 0.f}, br = avk, kr = avk;
#pragma unroll
        for (int ks = 0; ks < 2; ++ks) {
          const bf16x8 ktf = *(const bf16x8*)(kth + ks * 32 + fq * 8), btf = *(const bf16x8*)(bth + ks * 32 + fq * 8);
          const bf16x8 qf = *(const bf16x8*)(qh + ks * 32 + fq * 8), rf = *(const bf16x8*)(rh + ks * 32 + fq * 8);
          avk = MFMA16(ktf, qf, avk); br = MFMA16(btf, rf, br); kr = MFMA16(ktf, rf, kr);
        }
        bf16x8 sp[2], qa[2], ra[2];
#pragma unroll
        for (int m = 0; m < 2; ++m) {
#pragma unroll
          for (int e = 0; e < 4; ++e) { sp[m][e] = (short)f2bf(accS[2 * m][e]); sp[m][4 + e] = (short)f2bf(accS[2 * m + 1][e]); }
          const uint2 q0 = *(const uint2*)(qh + 32 * m + fq * 4), q1 = *(const uint2*)(qh + 32 * m + 16 + fq * 4);
          const uint2 r0 = *(const uint2*)(rh + 32 * m + fq * 4), r1 = *(const uint2*)(rh + 32 * m + 16 + fq * 4);
          qa[m] = __builtin_bit_cast(bf16x8, make_uint4(q0.x, q0.y, q1.x, q1.y));
          ra[m] = __builtin_bit_cast(bf16x8, make_uint4(r0.x, r0.y, r1.x, r1.y));
        }
        uint2 vv = *(const uint2*)(VB + (bt * 64 + wl * 16 + fr) * 24 + fq * 4);
        if (MODE == 1 && w >= 4) vv = make_uint2(0u, 0u);
        const uint2 ntv = *(const uint2*)(NT + (bt * 16 + fr) * 16 + fq * 4);
        const int i0 = fq * 4;
        const bf16x8 v_op = __builtin_bit_cast(bf16x8, make_uint4(0u, 0u, vv.x, vv.y));
        const bf16x8 avk_op = __builtin_bit_cast(bf16x8, make_uint4(0u, 0u, pack2(i0 < fr ? avk[0] : 0.f, i0 + 1 < fr ? avk[1] : 0.f), pack2(i0 + 2 < fr ? avk[2] : 0.f, i0 + 3 < fr ? avk[3] : 0.f)));
        f32x4 z4 = {0.f, 0.f, 0.f, 0.f};
        f32x4 W = MFMA16(qa[0], sp[0], z4); W = MFMA16(qa[1], sp[1], W); W = MFMA16(avk_op, v_op, W);
        const bf16x8 nt_op = __builtin_bit_cast(bf16x8, make_uint4(ntv.x, ntv.y, 0u, 0u));
        const bf16x8 w_op = __builtin_bit_cast(bf16x8, make_uint4(pack2(W[0], W[1]), pack2(W[2], W[3]), 0u, 0u));
        const f32x4 Uu = MFMA16(nt_op, w_op, z4);
        const bf16x8 uv_op = __builtin_bit_cast(bf16x8, make_uint4(pack2(Uu[0], Uu[1]), pack2(Uu[2], Uu[3]), vv.x, vv.y));
        const bf16x8 brkr_op = __builtin_bit_cast(bf16x8, make_uint4(pack2(i0 <= fr ? br[0] : 0.f, i0 + 1 <= fr ? br[1] : 0.f), pack2(i0 + 2 <= fr ? br[2] : 0.f, i0 + 3 <= fr ? br[3] : 0.f),
                                                                      pack2(i0 <= fr ? kr[0] : 0.f, i0 + 1 <= fr ? kr[1] : 0.f), pack2(i0 + 2 <= fr ? kr[2] : 0.f, i0 + 3 <= fr ? kr[3] : 0.f)));
        f32x4 O = MFMA16(ra[0], sp[0], z4); O = MFMA16(ra[1], sp[1], O); O = MFMA16(brkr_op, uv_op, O);
        if (MODE == 0) {
#pragma unroll
          for (int e = 0; e < 4; ++e) OO[(bt * 16 + fq * 4 + e) * 64 + w * 16 + fr] = O[e];
        }
#pragma unroll
        for (int tk = 0; tk < 4; ++tk) {
          const float4 g4 = *(const float4*)(GT + bt * 64 + tk * 16 + fq * 4);
          f32x4 a = accS[tk]; a[0] *= g4.x; a[1] *= g4.y; a[2] *= g4.z; a[3] *= g4.w;
          const bf16x8 bk = *(const bf16x8*)(BKE + (bt * 64 + tk * 16 + fr) * 40 + fq * 8);
          accS[tk] = MFMA16(bk, uv_op, a);
        }
      }
    }
#endif
    __syncthreads();
    if (MODE == 0) {
      const int t = tid >> 3, r8 = (tid & 7) * 8;
      const int pc = dir ? 63 - t : t;
      const float* src = OO + t * 64 + r8;
      uint4 o; o.x = pack2(src[0], src[1]); o.y = pack2(src[2], src[3]); o.z = pack2(src[4], src[5]); o.w = pack2(src[6], src[7]);
      *(uint4*)(OUTB + (size_t)(tb + Pbase + pc) * ostride + ocol + r8) = o;
    }
  }
  if (MODE == 1) {
    float* dst = (float*)(p.ws + OFF_SLOC) + (size_t)(sbase + g) * 8192 + (w >= 4 ? 4096 : 0);
#pragma unroll
    for (int tk = 0; tk < 4; ++tk) *(float4*)(dst + (wl * 16 + fr) * 64 + tk * 16 + fq * 4) = make_float4(accS[tk][0], accS[tk][1], accS[tk][2], accS[tk][3]);
  }
  __syncthreads();
}

DEVI void attn_task(const P& p, char* smem, int blk, int g) {
  bf16_t* KR = (bf16_t*)smem;
  bf16_t* VT = KR + 384 * 72;
  int tid; asm volatile("v_mov_b32 %0, %1" : "=v"(tid) : "v"(threadIdx.x));
  const int lane = tid & 63, w = tid >> 6, fr = lane & 15, fq = lane >> 4;
  const int tok0 = blk * 128, s = tok_seq(tok0);
  int L, tb; seq_info(s, L, tb);
  const int nb = (tok0 - tb) >> 7;
  const float2* ROPE = (const float2*)(p.ws + OFF_ROPE);
  const bf16_t* U = (const bf16_t*)(p.ws + OFF_U);
  bf16_t* H = (bf16_t*)(p.ws + OFF_H);
  __syncthreads();
#pragma unroll 4
  for (int it = 0; it < 24; ++it) {
    const int i = tid + it * NTHR;
    const int key = i >> 5, d = i & 31, kpos = (nb - 1) * 128 + key;
    const bool ok = kpos >= 0 && kpos < L;
    const int kc = kpos < 0 ? 0 : (kpos >= L ? L - 1 : kpos);
    const bf16_t* row = U + (size_t)(tb + kc) * OD_IN + 512 + g * 64;
    const float a = bf2f(row[d]), b = bf2f(row[d + 32]); const float2 cs = ROPE[kc * 32 + d];
    const float k1 = ok ? a * cs.x - b * cs.y : 0.f, k2 = ok ? b * cs.x + a * cs.y : 0.f;
    KR[key * 72 + d] = f2bf(k1); KR[key * 72 + d + 32] = f2bf(k2);
  }
#pragma unroll 8
  for (int it = 0; it < 48; ++it) {
    const int i = tid + it * NTHR;
    const int key = i >> 6, d = i & 63, kpos = (nb - 1) * 128 + key;
    const bool ok = kpos >= 0 && kpos < L;
    const int kc = kpos < 0 ? 0 : (kpos >= L ? L - 1 : kpos);
    const bf16_t v = U[(size_t)(tb + kc) * OD_IN + 640 + g * 64 + d];
    VT[d * 392 + key] = ok ? v : (bf16_t)0;
  }
  __syncthreads();
  const int hq = g * 4 + (w >> 1);
  const float sink = p.swa_sink[hq];
  uint4 rqa, rqb; float4 rcs[4];
  auto issue_q = [&](int mt_) {
    const int qp = nb * 128 + (w & 1) * 64 + mt_ * 16 + fr;
    const bf16_t* row = U + ((size_t)tb + qp) * OD_IN + hq * 64;
    rqa = *(const uint4*)(row + fq * 8); rqb = *(const uint4*)(row + 32 + fq * 8);
    const float4* rp = (const float4*)(ROPE + qp * 32 + fq * 8);
    rcs[0] = rp[0]; rcs[1] = rp[1]; rcs[2] = rp[2]; rcs[3] = rp[3];
  };
  issue_q(0);
  for (int mt = 0; mt < 4; ++mt) {
    const int qloc = (w & 1) * 64 + mt * 16 + fr, qpos = nb * 128 + qloc;
    const size_t tokq = (size_t)tb + qpos;
    bf16x8 qf[2];
    {
      float qa[8], qb[8]; unpack8(rqa, qa); unpack8(rqb, qb);
#pragma unroll
      for (int j = 0; j < 4; ++j) {
        const float4 cs = rcs[j];
        qf[0][2 * j] = (short)f2bf((qa[2 * j] * cs.x - qb[2 * j] * cs.y) * 0.125f); qf[1][2 * j] = (short)f2bf((qb[2 * j] * cs.x + qa[2 * j] * cs.y) * 0.125f);
        qf[0][2 * j + 1] = (short)f2bf((qa[2 * j + 1] * cs.z - qb[2 * j + 1] * cs.w) * 0.125f); qf[1][2 * j + 1] = (short)f2bf((qb[2 * j + 1] * cs.z + qa[2 * j + 1] * cs.w) * 0.125f);
      }
    }
    if (mt < 3) issue_q(mt + 1);
    const int q16 = (w & 1) * 4 + mt;
    f32x4 sc[17];
#pragma unroll
    for (int i = 0; i < 17; ++i) {
      const int nt = q16 + i;
      f32x4 a = {0.f, 0.f, 0.f, 0.f};
#pragma unroll
      for (int ks = 0; ks < 2; ++ks) { bf16x8 kf = *(const bf16x8*)(KR + (nt * 16 + fr) * 72 + ks * 32 + fq * 8); a = MFMA16(kf, qf[ks], a); }
      sc[i] = a;
    }
    float m = sink;
#pragma unroll
    for (int i = 0; i < 17; ++i)
#pragma unroll
      for (int e = 0; e < 4; ++e) {
        const int key = (q16 + i) * 16 + fq * 4 + e, rel = key - 128 - qloc, kpos = (nb - 1) * 128 + key;
        const bool valid = rel >= -128 && rel <= 128 && kpos >= 0 && kpos < L;
        sc[i][e] = valid ? sc[i][e] : -1e30f;
        m = fmaxf(m, sc[i][e]);
      }
    m = fmaxf(m, __shfl_xor(m, 16)); m = fmaxf(m, __shfl_xor(m, 32));
    float sum = 0.f;
#pragma unroll
    for (int i = 0; i < 17; ++i)
#pragma unroll
      for (int e = 0; e < 4; ++e) { const float pv = __expf(sc[i][e] - m); sc[i][e] = pv; sum += pv; }
    sum += __shfl_xor(sum, 16); sum += __shfl_xor(sum, 32);
    const float rden = 1.f / (sum + __expf(sink - m));
    f32x4 o[4];
#pragma unroll
    for (int dt = 0; dt < 4; ++dt) o[dt] = (f32x4){0.f, 0.f, 0.f, 0.f};
#pragma unroll
    for (int mm = 0; mm < 9; ++mm) {
      bf16x8 pf;
#pragma unroll
      for (int e = 0; e < 4; ++e) { pf[e] = (short)f2bf(sc[2 * mm][e]); pf[4 + e] = mm < 8 ? (short)f2bf(sc[mm < 8 ? 2 * mm + 1 : 16][e]) : (short)0; }
      const int k0 = (q16 + 2 * mm) * 16 + fq * 4, k1 = (mm < 8 ? (q16 + 2 * mm + 1) : q16) * 16 + fq * 4;
#pragma unroll
      for (int dt = 0; dt < 4; ++dt) {
        const bf16_t* vr = VT + (dt * 16 + fr) * 392;
        const uint2 lo = *(const uint2*)(vr + k0), hi = *(const uint2*)(vr + k1);
        uint4 pk = make_uint4(lo.x, lo.y, hi.x, hi.y);
        o[dt] = MFMA16(__builtin_bit_cast(bf16x8, pk), pf, o[dt]);
      }
    }
#pragma unroll
    for (int dt = 0; dt < 4; ++dt) {
      const int d0 = dt * 16 + fq * 4;
      const uint2 gv = *(const uint2*)(U + tokq * OD_IN + 768 + hq * 64 + d0);
      const float g0 = __uint_as_float(gv.x << 16), g1 = __uint_as_float(gv.x & 0xffff0000u), g2 = __uint_as_float(gv.y << 16), g3 = __uint_as_float(gv.y & 0xffff0000u);
      uint2 ov; ov.x = pack2(o[dt][0] * rden * silu(g0), o[dt][1] * rden * silu(g1)); ov.y = pack2(o[dt][2] * rden * silu(g2), o[dt][3] * rden * silu(g3));
      *(uint2*)(H + tokq * D + hq * 64 + d0) = ov;
    }
  }
  __syncthreads();
}
#define XB_TMO      128
#define XB_XCNT(j)  (256  + 64 * (j))
#define XB_XSUB(j)  (1280 + 64 * (j))
#define XB_XGEN(j)  (2304 + 64 * (j))
#define XB_TOP      3328
#define XB_TOPGEN   3392
#define XCD_BAR_WORDS 3456
#define XB_SPIN_CAP (1u << 18)
#define XLAS __attribute__((address_space(3)))

__device__ __forceinline__ unsigned xb_ld(unsigned* p)              { return __hip_atomic_load(p, __ATOMIC_RELAXED, __HIP_MEMORY_SCOPE_AGENT); }
__device__ __forceinline__ unsigned xb_add(unsigned* p, unsigned v) { return __hip_atomic_fetch_add(p, v, __ATOMIC_RELAXED, __HIP_MEMORY_SCOPE_AGENT); }
__device__ __forceinline__ unsigned xb_xcc_id() { return (unsigned)__builtin_amdgcn_s_getreg((3 << 11) | 20) & 0xFu; }
#define XB_SPIN(cond, bar) do { unsigned _sp = 0; while (cond) { __builtin_amdgcn_s_sleep(1); \
    if ((++_sp & 255u) == 0u) { if (xb_ld(&(bar)[XB_TMO])) break; if (_sp > XB_SPIN_CAP) { atomicAdd(&(bar)[XB_TMO], 1u); break; } } } } while (0)

struct XcdBarrier {
    unsigned* bar; unsigned x;
    volatile XLAS unsigned* st;
};

__device__ __forceinline__ XcdBarrier xcd_barrier_post(unsigned* bar, volatile XLAS unsigned* st) {
    XcdBarrier b; b.bar = bar; b.x = xb_xcc_id(); b.st = st;
    if (threadIdx.x == 0) (void)xb_add(&bar[XB_XCNT(b.x)], 1u);
    return b;
}
__device__ __forceinline__ void xcd_barrier_complete(unsigned* bar, unsigned x, unsigned& nloc, unsigned& nx) {
    const unsigned G = gridDim.x * gridDim.y * gridDim.z;
    unsigned sum, cnt, mine, sp = 0u;
    for (;;) {
        sum = 0u; cnt = 0u; mine = 0u;
#pragma unroll
        for (unsigned j = 0; j < 16; ++j) { const unsigned c = xb_ld(&bar[XB_XCNT(j)]); sum += c; cnt += (c > 0u) ? 1u : 0u; mine = (j == x) ? c : mine; }
        if (sum == G) break;
        __builtin_amdgcn_s_sleep(1);
        if ((++sp & 255u) == 0u) { if (xb_ld(&bar[XB_TMO])) break; if (sp > XB_SPIN_CAP) { atomicAdd(&bar[XB_TMO], 1u); break; } }
    }
    nloc = mine > 0u ? mine : 1u; nx = cnt > 0u ? cnt : 1u;
}

__device__ __forceinline__ void xcd_barrier(const XcdBarrier& b) {
    asm volatile("s_waitcnt vmcnt(0)" ::: "memory");
    __syncthreads();
    if (threadIdx.x == 0) {
        unsigned* bar = b.bar;
        __builtin_amdgcn_s_waitcnt(0);
        unsigned nloc = b.st[0], nx = b.st[1];
        if (nloc == 0u) { xcd_barrier_complete(bar, b.x, nloc, nx); b.st[0] = nloc; b.st[1] = nx; }
        const unsigned old = xb_add(&bar[XB_XSUB(b.x)], 1u);
        const unsigned gen = old / nloc;
        if (old + 1u == (gen + 1u) * nloc) {
            __builtin_amdgcn_fence(__ATOMIC_RELEASE, "agent");
            asm volatile("s_waitcnt vmcnt(0)" ::: "memory");
            const unsigned og = xb_add(&bar[XB_TOP], 1u);
            const unsigned tg = og / nx;
            if (og + 1u == (tg + 1u) * nx) xb_add(&bar[XB_TOPGEN], 1u);
            else XB_SPIN(xb_ld(&bar[XB_TOPGEN]) == tg, bar);
            __builtin_amdgcn_fence(__ATOMIC_ACQUIRE, "agent");
            xb_add(&bar[XB_XGEN(b.x)], 1u);
            asm volatile("s_waitcnt vmcnt(0)" ::: "memory");
        } else {
            XB_SPIN(xb_ld(&bar[XB_XGEN(b.x)]) == gen, bar);
            __builtin_amdgcn_fence(__ATOMIC_ACQUIRE, "agent");
            asm volatile("s_waitcnt vmcnt(0)" ::: "memory");
        }
    }
    __syncthreads();
}


#ifndef PHMASK
#define PHMASK 0xFFF
#endif
DEVI int next_task(unsigned* cnt, int* sh) { __syncthreads(); if (threadIdx.x == 0) *sh = (int)atomicAdd(cnt, 1u); __syncthreads(); return *sh; }
DEVI void decode_chain(int id, int& s, int& rem) { if (id < 32) { s = id >> 4; rem = id & 15; } else { s = 2 + ((id - 32) >> 4); rem = (id - 32) & 15; } }

__global__ void __launch_bounds__(512, 2) mega(P p) {
  extern __shared__ __attribute__((aligned(16))) char smem[];
  __shared__ uint4 xb_words;
  if (threadIdx.x == 0) xb_words = make_uint4(0u, 0u, 0u, 0u);
  __syncthreads();
  const XcdBarrier xb = xcd_barrier_post((unsigned*)(p.ws + OFF_BAR), (volatile XLAS unsigned*)&xb_words);
  int& sh_task = *((int*)&xb_words + 2);
  cg::grid_group grid = cg::this_grid();
  unsigned* cnt = (unsigned*)(p.ws + OFF_CNT);
  const bf16_t* Hc = (const bf16_t*)(p.ws + OFF_H);
  const float* MOD = (const float*)(p.ws + OFF_MOD);
#ifndef DUPMASK
#define DUPMASK 0
#endif
#define PH_ON(k) ((PHMASK & (1 << (k))) && p.ph_lo <= (k) && (k) < p.ph_hi)
#define REP(k) for (int rep_ = 0; rep_ < ((DUPMASK >> (k)) & 1) + 1; ++rep_)
#define PH_SYNC(k) if (p.ph_lo <= (k) && (k) + 1 < p.ph_hi) { if ((k) == 0) grid.sync(); else xcd_barrier(xb); }
  if (PH_ON(0)) REP(0) phase_prep(p, smem);
  PH_SYNC(0);
  if (PH_ON(1)) REP(1) phase_modulate0(p);
  PH_SYNC(1);
  if (PH_ON(2)) REP(2) { EpiU e{(bf16_t*)(p.ws + OFF_U), EV_IN, EV_IN, (const float*)(p.ws + OFF_LB), 1}; gemm_phase(Hc, (const bf16_t*)(p.ws + OFF_WIN0), NTOK, EV_PAD, D, e, smem); }
  PH_SYNC(2);
#ifndef DUP3
#define DUP3 1
#endif
#ifndef DUP8
#define DUP8 1
#endif
  if (PH_ON(3)) {
    int id;
    while ((id = next_task(cnt + 2, &sh_task)) < 224) {
      const int ci = id / 7, g = id % 7, s = ci >> 4, rem = ci & 15, h = (rem >> 1) & 3, dir = rem & 1;
      if ((rem >> 3) == 0) scan0_task<128, 0, 1>(p, smem, s, h, dir, g * 32, 32, ci * 7, g); else scan0_task<64, 1, 1>(p, smem, s, h, dir, g * 32, 32, ci * 7, g);
    }
    xcd_barrier(xb);
    while ((id = next_task(cnt + 3, &sh_task)) < 512) {
      int s, rem, n0 = 0, nc = 64, sb = 0, g = 0;
      if (id < 256) { s = 2 + (id >> 4); rem = id & 15; }
      else { const int a = id - 256, ci = a >> 3; g = a & 7; s = ci >> 4; rem = ci & 15; n0 = g * 32; nc = 32; sb = ci * 7; }
      const int h = (rem >> 1) & 3, dir = rem & 1;
      if ((rem >> 3) == 0) scan0_task<128, 0, 0>(p, smem, s, h, dir, n0, nc, sb, g); else scan0_task<64, 1, 0>(p, smem, s, h, dir, n0, nc, sb, g);
    }
  }
  PH_SYNC(3);
  if (PH_ON(4)) phase_combine0(p);
  PH_SYNC(4);
  if (PH_ON(5)) REP(5) { EpiU e{(bf16_t*)(p.ws + OFF_U), D, D, (const float*)(p.ws + OFF_LB), 0}; gemm_phase(Hc, (const bf16_t*)(p.ws + OFF_WOUT0), NTOK, D, D, e, smem); }
  PH_SYNC(5);
  if (PH_ON(6)) phase_ln(p, 0);
  PH_SYNC(6);
  if (PH_ON(7)) REP(7) { EpiU e{(bf16_t*)(p.ws + OFF_U), OD_IN, OD_IN, (const float*)(p.ws + OFF_LB), 0}; gemm_phase(Hc, (const bf16_t*)(p.ws + OFF_WIN1), NTOK, OD_PAD, D, e, smem); }
  PH_SYNC(7);
  if (PH_ON(8)) {
    int id;
#ifndef NO_R0
    while ((id = next_task(cnt + 16, &sh_task)) < 256) { if (id & 1) rwkv_task<0, 1>(p, smem, 2 + (id >> 4), (id & 15) >> 1, 0, 64, 0, 0); else rwkv_task<0, 0>(p, smem, 2 + (id >> 4), (id & 15) >> 1, 0, 64, 0, 0); }
#endif
#ifndef NO_R1
    while ((id = next_task(cnt + 19, &sh_task)) < 224) { const int ci = id / 7, g = id % 7; if (ci & 1) rwkv_task<1, 1>(p, smem, ci >> 4, (ci & 15) >> 1, g * 32, 32, ci * 7, g); else rwkv_task<1, 0>(p, smem, ci >> 4, (ci & 15) >> 1, g * 32, 32, ci * 7, g); }
#endif
    while ((id = next_task(cnt + 18, &sh_task)) < 768) attn_task(p, smem, id >> 1, id & 1);
    xcd_barrier(xb);
#ifndef NO_R2
    while ((id = next_task(cnt + 17, &sh_task)) < 256) { const int ci = id >> 3, g = id & 7; if (ci & 1) rwkv_task<0, 1>(p, smem, ci >> 4, (ci & 15) >> 1, g * 32, 32, ci * 7, g); else rwkv_task<0, 0>(p, smem, ci >> 4, (ci & 15) >> 1, g * 32, 32, ci * 7, g); }
#endif
    while ((id = next_task(cnt + 20, &sh_task)) < 768) attn_task(p, smem, (id + 768) >> 1, id & 1);
  }
  PH_SYNC(8);
  if (PH_ON(9)) phase_rwkv_post(p);
  PH_SYNC(9);
  if (PH_ON(10)) { EpiU e{(bf16_t*)(p.ws + OFF_U), D, D, (const float*)(p.ws + OFF_LB), 0}; gemm_phase(Hc, (const bf16_t*)(p.ws + OFF_WOUT1), NTOK, D, D, e, smem); }
  PH_SYNC(10);
  if (PH_ON(11)) phase_ln(p, 1);
}

constexpr int NPH = 12;
constexpr bool ONE_LAUNCH = true;
extern "C" void kernel_launch(void* const* d_in, const int* in_sizes, int n_in, void* d_out, int out_size, void* d_ws, size_t ws_size, hipStream_t stream) {
  P p{};
  const float** f = (const float**)&p;
  for (int i = 0; i < 32; ++i) f[i] = (const float*)d_in[i];
  p.out = (float*)d_out; p.ws = (unsigned char*)d_ws; p.ph_lo = 0; p.ph_hi = NPH;
  static int grid_blocks = 0;
  if (!grid_blocks) {
    (void)hipFuncSetAttribute((const void*)mega, hipFuncAttributeMaxDynamicSharedMemorySize, LDS_BYTES);
    int dev = 0, cus = 0, per_cu = 0;
    (void)hipGetDevice(&dev);
    (void)hipDeviceGetAttribute(&cus, hipDeviceAttributeMultiprocessorCount, dev);
    (void)hipOccupancyMaxActiveBlocksPerMultiprocessor(&per_cu, mega, NTHR, LDS_BYTES);
    if (per_cu > 1) per_cu = 1;
    grid_blocks = cus * per_cu;
  }
  if (ws_size < WS_NEED || grid_blocks <= 0) { fprintf(stderr, "ws too small or no occupancy: %zu < %zu, grid %d\n", ws_size, WS_NEED, grid_blocks); return; }
  if (ONE_LAUNCH) {
    (void)hipMemsetAsync((unsigned char*)d_ws + OFF_BAR, 0, 16384, stream);
    void* args[] = {&p};
    hipError_t e = hipLaunchCooperativeKernel((void*)mega, dim3(grid_blocks), dim3(NTHR), args, LDS_BYTES, stream);
    if (e != hipSuccess) fprintf(stderr, "cooperative launch failed: %s (grid %d)\n", hipGetErrorString(e), grid_blocks);
  } else {
    for (int ph = 0; ph < NPH; ++ph) { P q = p; q.ph_lo = ph; q.ph_hi = ph + 1; hipLaunchKernelGGL(mega, dim3(grid_blocks), dim3(NTHR), LDS_BYTES, stream, q); }
  }
}
```

```cpp
#include <hip/hip_runtime.h>
#include <hip/hip_cooperative_groups.h>
#include <cstdio>
namespace cg = cooperative_groups;

#define DEVI __device__ __forceinline__
typedef unsigned short bf16_t;
typedef short bf16x8 __attribute__((ext_vector_type(8)));
typedef float f32x4 __attribute__((ext_vector_type(4)));

constexpr int D = 1024;
constexpr int NTOK = 98304, NPT = 32768;
constexpr int NSEQ = 18;
constexpr int EV_IN = 4128, EV_PAD = 4352;
constexpr int OD_IN = 3424, OD_PAD = 3584;
constexpr float ALPHA = 1.4142135623730951f;
constexpr int LDS_BYTES = 155648;
constexpr int NTHR = 512;

constexpr size_t al256(size_t x) { return (x + 255) & ~(size_t)255; }
constexpr size_t OFF_CNT = 0;
constexpr size_t OFF_LB = 4096;
constexpr size_t OFF_MOD = OFF_LB + 4096;
constexpr size_t OFF_BONUS = al256(OFF_MOD + (size_t)2 * NSEQ * 3072 * 4);
constexpr size_t OFF_ROPE = al256(OFF_BONUS + (size_t)NTOK * 8 * 4);
constexpr size_t OFF_WIN0 = al256(OFF_ROPE + (size_t)16384 * 32 * 8);
constexpr size_t OFF_WIN1 = al256(OFF_WIN0 + (size_t)EV_PAD * D * 2);
constexpr size_t OFF_WOUT0 = al256(OFF_WIN1 + (size_t)OD_PAD * D * 2);
constexpr size_t OFF_WOUT1 = al256(OFF_WOUT0 + (size_t)D * D * 2);
constexpr size_t OFF_H = al256(OFF_WOUT1 + (size_t)D * D * 2);
constexpr size_t OFF_U = al256(OFF_H + (size_t)NTOK * D * 2);
constexpr size_t OFF_OB1 = al256(OFF_U + (size_t)NTOK * OD_IN * 2);
constexpr size_t OFF_SLOC = al256(OFF_U + (size_t)NTOK * EV_IN * 2);
constexpr size_t OFF_DTOT = al256(OFF_SLOC + (size_t)224 * 128 * 128 * 4);
constexpr size_t OFF_BAR = al256(OFF_DTOT + (size_t)224 * 128 * 4);
constexpr size_t WS_NEED = OFF_BAR + 16384;
static_assert(WS_NEED <= (size_t)1073741824, "workspace fits 4x largest tensor");
static_assert(OFF_OB1 + (size_t)NTOK * 512 * 2 <= OFF_SLOC, "ob1 fits");

struct P {
  const float *x_prompt, *x_sample, *c_prompt, *c_sample;
  const float *ev_w_mod, *ev_b_mod, *ev_w_in, *lb_logits, *hgrn_norm, *gla_w_gk, *gla_b_gk, *gla_norm, *ev_w_out, *ev_ln_g, *ev_ln_b;
  const float *od_w_mod, *od_b_mod, *od_w_in, *swa_sink, *rwkv_mix, *rwkv_w0, *rwkv_w_w2, *rwkv_a0, *rwkv_a_w2, *rwkv_k_k, *rwkv_k_a,
      *rwkv_r_k, *rwkv_ln_w, *rwkv_ln_b, *od_w_out, *od_ln_g, *od_ln_b;
  float* out;
  unsigned char* ws;
  int ph_lo, ph_hi;
};

typedef float f32x2_t __attribute__((ext_vector_type(2)));
typedef __bf16 bf16x2_t __attribute__((ext_vector_type(2)));
DEVI unsigned pack2(float a, float b) { f32x2_t v = {a, b}; bf16x2_t r = __builtin_convertvector(v, bf16x2_t); return __builtin_bit_cast(unsigned, r); }
DEVI bf16_t f2bf(float f) { return (bf16_t)(pack2(f, 0.f) & 0xffffu); }
DEVI float bf2f(bf16_t h) { return __uint_as_float(((unsigned)h) << 16); }
DEVI float frcp(float x) { return __builtin_amdgcn_rcpf(x); }
DEVI float sigm(float x) { return frcp(1.f + __expf(-x)); }
DEVI float silu(float x) { return x * frcp(1.f + __expf(-x)); }
DEVI float softplusf(float x) { return x > 20.f ? x : __logf(1.f + __expf(x)); }
DEVI float ftanh(float x) { return 1.f - 2.f * frcp(1.f + __expf(2.f * x)); }
DEVI void seq_info(int s, int& L, int& tb) { if (s < 2) { L = 16384; tb = s * 16384; } else { L = 4096; tb = NPT + (s - 2) * 4096; } }
DEVI int tok_seq(int tok) { return tok < NPT ? (tok >> 14) : 2 + ((tok - NPT) >> 12); }
template <int CTRL> DEVI float dpp_f(float x) { return __builtin_bit_cast(float, __builtin_amdgcn_update_dpp(0, __builtin_bit_cast(int, x), CTRL, 0xf, 0xf, false)); }
DEVI float row16_sum(float x) {
  x += dpp_f<0xB1>(x);
  x += dpp_f<0x4E>(x);
  x += dpp_f<0x124>(x);
  x += dpp_f<0x128>(x);
  return x;
}
DEVI void reduce4_row16(float& a, float& b, float& c, float& d) {
  asm volatile(
      "s_nop 1\n\t"
      "v_add_f32_dpp %0, %0, %0 quad_perm:[1,0,3,2] row_mask:0xf bank_mask:0xf\n\t"
      "v_add_f32_dpp %1, %1, %1 quad_perm:[1,0,3,2] row_mask:0xf bank_mask:0xf\n\t"
      "v_add_f32_dpp %2, %2, %2 quad_perm:[1,0,3,2] row_mask:0xf bank_mask:0xf\n\t"
      "v_add_f32_dpp %3, %3, %3 quad_perm:[1,0,3,2] row_mask:0xf bank_mask:0xf\n\t"
      "v_add_f32_dpp %0, %0, %0 quad_perm:[2,3,0,1] row_mask:0xf bank_mask:0xf\n\t"
      "v_add_f32_dpp %1, %1, %1 quad_perm:[2,3,0,1] row_mask:0xf bank_mask:0xf\n\t"
      "v_add_f32_dpp %2, %2, %2 quad_perm:[2,3,0,1] row_mask:0xf bank_mask:0xf\n\t"
      "v_add_f32_dpp %3, %3, %3 quad_perm:[2,3,0,1] row_mask:0xf bank_mask:0xf\n\t"
      "v_add_f32_dpp %0, %0, %0 row_ror:4 row_mask:0xf bank_mask:0xf\n\t"
      "v_add_f32_dpp %1, %1, %1 row_ror:4 row_mask:0xf bank_mask:0xf\n\t"
      "v_add_f32_dpp %2, %2, %2 row_ror:4 row_mask:0xf bank_mask:0xf\n\t"
      "v_add_f32_dpp %3, %3, %3 row_ror:4 row_mask:0xf bank_mask:0xf\n\t"
      "v_add_f32_dpp %0, %0, %0 row_ror:8 row_mask:0xf bank_mask:0xf\n\t"
      "v_add_f32_dpp %1, %1, %1 row_ror:8 row_mask:0xf bank_mask:0xf\n\t"
      "v_add_f32_dpp %2, %2, %2 row_ror:8 row_mask:0xf bank_mask:0xf\n\t"
      "v_add_f32_dpp %3, %3, %3 row_ror:8 row_mask:0xf bank_mask:0xf\n\t"
      "s_nop 1"
      : "+v"(a), "+v"(b), "+v"(c), "+v"(d));
}
DEVI void reduce2_row16(float& a, float& b) {
  asm volatile(
      "s_nop 1\n\t"
      "v_add_f32_dpp %0, %0, %0 quad_perm:[1,0,3,2] row_mask:0xf bank_mask:0xf\n\t"
      "v_add_f32_dpp %1, %1, %1 quad_perm:[1,0,3,2] row_mask:0xf bank_mask:0xf\n\t"
      "s_nop 0\n\t"
      "v_add_f32_dpp %0, %0, %0 quad_perm:[2,3,0,1] row_mask:0xf bank_mask:0xf\n\t"
      "v_add_f32_dpp %1, %1, %1 quad_perm:[2,3,0,1] row_mask:0xf bank_mask:0xf\n\t"
      "s_nop 0\n\t"
      "v_add_f32_dpp %0, %0, %0 row_ror:4 row_mask:0xf bank_mask:0xf\n\t"
      "v_add_f32_dpp %1, %1, %1 row_ror:4 row_mask:0xf bank_mask:0xf\n\t"
      "s_nop 0\n\t"
      "v_add_f32_dpp %0, %0, %0 row_ror:8 row_mask:0xf bank_mask:0xf\n\t"
      "v_add_f32_dpp %1, %1, %1 row_ror:8 row_mask:0xf bank_mask:0xf\n\t"
      "s_nop 1"
      : "+v"(a), "+v"(b));
}
DEVI float wave_sum(float x) { for (int o = 32; o > 0; o >>= 1) x += __shfl_xor(x, o); return x; }

constexpr int BM = 256, BK = 64, HALF = 128, NXCD = 8, WGM = 8, HT = HALF * BK;
DEVI int lds_byte(int r, int c) { int st = (r >> 4) * 2 + (c >> 5), rr = r & 15, cc = c & 31, ob = rr * 64 + cc * 2; return st * 1024 + (ob ^ (((ob >> 9) & 1) << 5)); }
DEVI void stage_rc(int b, int& R, int& C) { int st = b / 1024, sb = b % 1024, swz = sb ^ (((sb >> 9) & 1) << 5); R = (st >> 1) * 16 + swz / 64; C = (st & 1) * 32 + (swz % 64) / 2; }

template <class Epi>
DEVI void gemm_phase(const bf16_t* __restrict__ A, const bf16_t* __restrict__ Bt, int M, int N, int K, const Epi& epi, char* smem) {
  bf16_t* shm = (bf16_t*)smem;
#define SA(b, h) (shm + ((b) * 2 + (h)) * HT)
#define SB(b, h) (shm + (4 + (b) * 2 + (h)) * HT)
#define STAGE(Pp, BASE, br, kt) do { const bf16_t* _gb = (BASE) + (long)(br) * K + (long)(kt) * BK; \
    __builtin_amdgcn_global_load_lds((const unsigned*)(_gb + soff0), (__attribute__((address_space(3))) unsigned*)((char*)(Pp) + threadIdx.x * 16), 16, 0, 0); \
    __builtin_amdgcn_global_load_lds((const unsigned*)(_gb + (long)64 * K + soff0), (__attribute__((address_space(3))) unsigned*)((char*)(Pp) + threadIdx.x * 16 + 8192), 16, 0, 0); } while (0)
#define LDA(dst, b, h) for (int m = 0; m < 4; ++m) for (int k = 0; k < 2; ++k) \
    dst[m][k] = *reinterpret_cast<const bf16x8*>((char*)SA(b, h) + aoff + (m * 2 + k) * 1024)
#define LDB(dst, b, h) for (int n = 0; n < 2; ++n) for (int k = 0; k < 2; ++k) \
    dst[n][k] = *reinterpret_cast<const bf16x8*>((char*)SB(b, h) + boff + (n * 2 + k) * 1024)
#define MMA(ai, bj, At_, Bt_) do { __builtin_amdgcn_s_setprio(1); \
    for (int m = 0; m < 4; ++m) for (int n = 0; n < 2; ++n) for (int k = 0; k < 2; ++k) \
      acc[ai][bj][m][n] = __builtin_amdgcn_mfma_f32_16x16x32_bf16(Bt_[n][k], At_[m][k], acc[ai][bj][m][n], 0, 0, 0); \
    __builtin_amdgcn_s_setprio(0); } while (0)
#define WAIT_V(n) asm volatile("s_waitcnt vmcnt(" #n ")" ::: "memory")
#define WAIT_L(n) asm volatile("s_waitcnt lgkmcnt(" #n ")" ::: "memory")
#define BAR __builtin_amdgcn_s_barrier()
#define SCHED __builtin_amdgcn_sched_barrier(0)
  const int nM = M / BM, nN = N / BM, nwg = nM * nN;
  const int wid = threadIdx.x >> 6, lane = threadIdx.x & 63, wr = wid >> 2, wc = wid & 3, fr = lane & 15, fq = lane >> 4;
  const int nt = K / BK;
  unsigned soff0;
  { int _r, _c; stage_rc(threadIdx.x * 16, _r, _c); soff0 = (unsigned)(_r * K + _c); }
  const int aoff = lds_byte(wr * 64 + fr, fq * 8), boff = lds_byte(wc * 32 + fr, fq * 8);
  for (int Lw = blockIdx.x; Lw < nwg; Lw += gridDim.x) {
    int wgid = Lw;
    { int q = nwg / NXCD, r = nwg % NXCD, xcd = wgid % NXCD, off = wgid / NXCD; wgid = (xcd < r ? xcd * (q + 1) : r * (q + 1) + (xcd - r) * q) + off; }
    int nig = WGM * nN, gid = wgid / nig, fm = gid * WGM, gsz = min(nM - fm, WGM);
    int pm = fm + ((wgid % nig) % gsz), pn = (wgid % nig) / gsz, brow = pm * BM, bcol = pn * BM;
    f32x4 acc[2][2][4][2] = {};
    bf16x8 At[4][2], B0[2][2], B1[2][2];
    STAGE(SB(0, 0), Bt, bcol, 0); STAGE(SA(0, 0), A, brow, 0);
    STAGE(SB(0, 1), Bt, bcol + HALF, 0); STAGE(SA(0, 1), A, brow + HALF, 0);
    if (wr == 1) BAR;
    WAIT_V(4); BAR;
    STAGE(SB(1, 0), Bt, bcol, 1); STAGE(SA(1, 0), A, brow, 1); STAGE(SB(1, 1), Bt, bcol + HALF, 1);
    WAIT_V(6); BAR;
    for (int t = 0; t < nt - 2; t += 2) {
      LDB(B0, 0, 0); SCHED; LDA(At, 0, 0); STAGE(SA(1, 1), A, brow + HALF, t + 1);
      WAIT_L(8); BAR; WAIT_L(0); MMA(0, 0, At, B0); BAR; SCHED;
      LDB(B1, 0, 1); STAGE(SB(0, 0), Bt, bcol, t + 2);
      BAR; WAIT_L(0); MMA(0, 1, At, B1); BAR;
      LDA(At, 0, 1); STAGE(SA(0, 0), A, brow, t + 2);
      BAR; WAIT_L(0); MMA(1, 0, At, B0); BAR; SCHED;
      STAGE(SB(0, 1), Bt, bcol + HALF, t + 2);
      WAIT_V(6); BAR; MMA(1, 1, At, B1); BAR;
      LDB(B0, 1, 0); SCHED; LDA(At, 1, 0); STAGE(SA(0, 1), A, brow + HALF, t + 2);
      WAIT_L(8); BAR; WAIT_L(0); MMA(0, 0, At, B0); BAR; SCHED;
      LDB(B1, 1, 1); STAGE(SB(1, 0), Bt, bcol, t + 3);
      BAR; WAIT_L(0); MMA(0, 1, At, B1); BAR;
      LDA(At, 1, 1); STAGE(SA(1, 0), A, brow, t + 3);
      BAR; WAIT_L(0); MMA(1, 0, At, B0); BAR; SCHED;
      STAGE(SB(1, 1), Bt, bcol + HALF, t + 3);
      WAIT_V(6); BAR; MMA(1, 1, At, B1); BAR;
    }
    { LDB(B0, 0, 0); LDA(At, 0, 0); STAGE(SA(1, 1), A, brow + HALF, nt - 1);
      BAR; WAIT_L(0); MMA(0, 0, At, B0); BAR;
      LDB(B1, 0, 1); BAR; WAIT_L(0); MMA(0, 1, At, B1); BAR;
      LDA(At, 0, 1); WAIT_V(4); BAR; WAIT_L(0); MMA(1, 0, At, B0); MMA(1, 1, At, B1); BAR; }
    { LDB(B0, 1, 0); LDA(At, 1, 0); WAIT_V(2); BAR; WAIT_L(0); MMA(0, 0, At, B0); BAR;
      LDB(B1, 1, 1); WAIT_V(0); BAR; WAIT_L(0); MMA(0, 1, At, B1); BAR;
      LDA(At, 1, 1); BAR; WAIT_L(0); MMA(1, 0, At, B0); MMA(1, 1, At, B1); BAR; }
    if (wr == 0) BAR;
#pragma unroll
    for (int ai = 0; ai < 2; ++ai)
#pragma unroll
      for (int m = 0; m < 4; ++m)
#pragma unroll
        for (int bj = 0; bj < 2; ++bj)
          epi(acc[ai][bj][m][0], acc[ai][bj][m][1], brow + ai * HALF + wr * 64 + m * 16 + fr, bcol + bj * HALF + wc * 32 + fq * 8);
    __syncthreads();
  }
#undef SA
#undef SB
#undef STAGE
#undef LDA
#undef LDB
#undef MMA
}

struct EpiU {
  bf16_t* U; int ldu; int nvalid; const float* LB; int act;
  DEVI void operator()(const f32x4& a0, const f32x4& a1, int row, int col) const {
    if (col < nvalid) {
      float v[8] = {a0[0], a0[1], a0[2], a0[3], a1[0], a1[1], a1[2], a1[3]};
      if (act) {
        if (col < 512) {
#pragma unroll
          for (int i = 0; i < 8; ++i) v[i] = silu(v[i]);
        } else if (col >= 1024 && col < 2048) {
          const float4 l0 = *(const float4*)(LB + (col - 1024)), l1 = *(const float4*)(LB + (col - 1024) + 4);
          const float lb[8] = {l0.x, l0.y, l0.z, l0.w, l1.x, l1.y, l1.z, l1.w};
#pragma unroll
          for (int i = 0; i < 8; ++i) v[i] = (1.f - lb[i]) * sigm(-v[i]);
        } else if (col >= 2560 && col < 2816) {
#pragma unroll
          for (int i = 0; i < 8; ++i) v[i] *= 0.125f;
        }
      }
      *(uint4*)(U + (size_t)row * ldu + col) = make_uint4(pack2(v[0], v[1]), pack2(v[2], v[3]), pack2(v[4], v[5]), pack2(v[6], v[7]));
    }
  }
};
struct EpiRes {
  const float* xp; const float* xs; float* out; const float* mod;
  DEVI void operator()(const f32x4& a, int row, int col) const {
    const float* xr = row < NPT ? xp + (size_t)row * D : xs + (size_t)(row - NPT) * D;
    float4 x = *(const float4*)(xr + col);
    float4 g = *(const float4*)(mod + tok_seq(row) * 3072 + 2048 + col);
    float4 o;
    o.x = ALPHA * x.x + (1.f + g.x) * a[0]; o.y = ALPHA * x.y + (1.f + g.y) * a[1];
    o.z = ALPHA * x.z + (1.f + g.z) * a[2]; o.w = ALPHA * x.w + (1.f + g.w) * a[3];
    *(float4*)(out + (size_t)row * D + col) = o;
  }
};

DEVI void phase_prep(const P& p, char* smem) {
  const int tid = threadIdx.x;
  unsigned char* ws = p.ws;
  if (blockIdx.x == 0) {
    if (tid < 64) ((unsigned*)(ws + OFF_CNT))[tid] = 0u;
    float* LB = (float*)(ws + OFF_LB);
    for (int i = tid; i < 1024; i += NTHR) { int dir = i >> 9, d = i & 511; float l0 = p.lb_logits[dir * 1024 + d], l1 = p.lb_logits[dir * 1024 + 512 + d]; LB[i] = 1.f / (1.f + __expf(l1 - l0)); }
  }
  {
    float2* R = (float2*)(ws + OFF_ROPE);
    for (int i = blockIdx.x * NTHR + tid; i < 16384 * 32; i += gridDim.x * NTHR) {
      int pos = i >> 5, j = i & 31;
      float inv = (float)exp(-(double)j * (9.210340371976184 / 32.0));
      float ang = (float)pos * inv;
      float sn, cs; sincosf(ang, &sn, &cs);
      R[i] = make_float2(cs, sn);
    }
  }
  constexpr int NJ_MOD = 48, T_IN0 = 16 * (EV_PAD / 64), T_IN1 = 16 * (OD_PAD / 64), T_OUT = 256, NJ = NJ_MOD + T_IN0 + T_IN1 + 2 * T_OUT;
  for (int job = blockIdx.x; job < NJ; job += gridDim.x) {
    if (job < NJ_MOD) {
      const int layer = job / 24, cgp = job % 24;
      const float* wm = layer ? p.od_w_mod : p.ev_w_mod; const float* bm = layer ? p.od_b_mod : p.ev_b_mod;
      float* SC = (float*)smem;
      float* RED = SC + NSEQ * 1024;
      for (int i = tid; i < NSEQ * 1024; i += NTHR) { int s_ = i >> 10, d = i & 1023; float c = s_ < 2 ? p.c_prompt[s_ * 1024 + d] : p.c_sample[(s_ - 2) * 1024 + d]; SC[i] = silu(c); }
      __syncthreads();
      const int oc = tid & 127, o = cgp * 128 + oc, dq = tid >> 7;
      float acc[NSEQ];
#pragma unroll
      for (int s_ = 0; s_ < NSEQ; ++s_) acc[s_] = 0.f;
#pragma unroll 8
      for (int d = dq * 256; d < dq * 256 + 256; ++d) {
        float wv = wm[(size_t)d * 3072 + o];
#pragma unroll
        for (int s_ = 0; s_ < NSEQ; ++s_) acc[s_] += SC[s_ * 1024 + d] * wv;
      }
#pragma unroll
      for (int s_ = 0; s_ < NSEQ; ++s_) RED[(dq * NSEQ + s_) * 128 + oc] = acc[s_];
      __syncthreads();
      float* MOD = (float*)(ws + OFF_MOD);
      for (int i = tid; i < NSEQ * 128; i += NTHR) {
        int s_ = i >> 7, c_ = i & 127;
        float v = RED[(0 * NSEQ + s_) * 128 + c_] + RED[(1 * NSEQ + s_) * 128 + c_] + RED[(2 * NSEQ + s_) * 128 + c_] + RED[(3 * NSEQ + s_) * 128 + c_];
        MOD[(size_t)(layer * NSEQ + s_) * 3072 + cgp * 128 + c_] = v + bm[cgp * 128 + c_];
      }
      __syncthreads();
    } else {
      int j = job - NJ_MOD; const float* W; bf16_t* dst; int N, Npad;
      if (j < T_IN0) { W = p.ev_w_in; dst = (bf16_t*)(ws + OFF_WIN0); N = EV_IN; Npad = EV_PAD; }
      else if ((j -= T_IN0) < T_IN1) { W = p.od_w_in; dst = (bf16_t*)(ws + OFF_WIN1); N = OD_IN; Npad = OD_PAD; }
      else if ((j -= T_IN1) < T_OUT) { W = p.ev_w_out; dst = (bf16_t*)(ws + OFF_WOUT0); N = 1024; Npad = 1024; }
      else { j -= T_OUT; W = p.od_w_out; dst = (bf16_t*)(ws + OFF_WOUT1); N = 1024; Npad = 1024; }
      const int ntn = Npad / 64, kt = j / ntn, ntile = j % ntn;
      float* T = (float*)smem;
      for (int i = tid; i < 4096; i += NTHR) { int kk = i >> 6, nn = i & 63; int n = ntile * 64 + nn; T[kk * 65 + nn] = n < N ? W[(size_t)(kt * 64 + kk) * N + n] : 0.f; }
      __syncthreads();
      for (int i = tid; i < 4096; i += NTHR) { int nn = i >> 6, kk = i & 63; { const int q = nn & 31, rho = (((q >> 2) & 1) << 4) | ((q >> 3) << 2) | (q & 3); dst[(size_t)(ntile * 64 + (nn & 32) + rho) * 1024 + kt * 64 + kk] = f2bf(T[kk * 65 + nn]); } }
      __syncthreads();
    }
  }
}

DEVI void phase_modulate0(const P& p) {
  const int lane = threadIdx.x & 63, gw = blockIdx.x * 8 + (threadIdx.x >> 6), nw = gridDim.x * 8;
  const float* MOD = (const float*)(p.ws + OFF_MOD);
  bf16_t* H = (bf16_t*)(p.ws + OFF_H);
  for (int row = gw; row < NTOK; row += nw) {
    const float* xr = row < NPT ? p.x_prompt + (size_t)row * D : p.x_sample + (size_t)(row - NPT) * D;
    const float* m = MOD + tok_seq(row) * 3072;
#pragma unroll
    for (int i = 0; i < 4; ++i) {
      int col = i * 256 + lane * 4;
      float4 x = *(const float4*)(xr + col), sh = *(const float4*)(m + col), sc = *(const float4*)(m + 1024 + col);
      uint2 o; o.x = pack2(x.x * (1.f + sc.x) + sh.x, x.y * (1.f + sc.y) + sh.y); o.y = pack2(x.z * (1.f + sc.z) + sh.z, x.w * (1.f + sc.w) + sh.w);
      *(uint2*)(H + (size_t)row * D + col) = o;
    }
  }
}

DEVI void phase_ln(const P& p, int layer) {
  const int lane = threadIdx.x & 63, gw = blockIdx.x * 8 + (threadIdx.x >> 6), nw = gridDim.x * 8;
  const float* MODL = (const float*)(p.ws + OFF_MOD) + (size_t)layer * NSEQ * 3072;
  const float* MOD1 = (const float*)(p.ws + OFF_MOD) + (size_t)NSEQ * 3072;
  bf16_t* H = (bf16_t*)(p.ws + OFF_H);
  const bf16_t* Y = (const bf16_t*)(p.ws + OFF_U);
  const float* lg = layer ? p.od_ln_g : p.ev_ln_g; const float* lb = layer ? p.od_ln_b : p.ev_ln_b;
  for (int row = gw; row < NTOK; row += nw) {
    float* xo = p.out + (size_t)row * D;
    const float* xr = layer ? xo : (row < NPT ? p.x_prompt + (size_t)row * D : p.x_sample + (size_t)(row - NPT) * D);
    const int sq = tok_seq(row);
    const float* mg = MODL + sq * 3072 + 2048;
    float4 v[4]; float sm = 0.f;
#pragma unroll
    for (int i = 0; i < 4; ++i) {
      const int col = i * 256 + lane * 4;
      const float4 x = *(const float4*)(xr + col), g = *(const float4*)(mg + col);
      const uint2 yv = *(const uint2*)(Y + (size_t)row * D + col);
      v[i].x = ALPHA * x.x + (1.f + g.x) * __uint_as_float(yv.x << 16); v[i].y = ALPHA * x.y + (1.f + g.y) * __uint_as_float(yv.x & 0xffff0000u);
      v[i].z = ALPHA * x.z + (1.f + g.z) * __uint_as_float(yv.y << 16); v[i].w = ALPHA * x.w + (1.f + g.w) * __uint_as_float(yv.y & 0xffff0000u);
      sm += v[i].x + v[i].y + v[i].z + v[i].w;
    }
    const float mu = wave_sum(sm) * (1.f / 1024.f);
    float sq2 = 0.f;
#pragma unroll
    for (int i = 0; i < 4; ++i) { float a = v[i].x - mu, b = v[i].y - mu, c = v[i].z - mu, d = v[i].w - mu; sq2 += a * a + b * b + c * c + d * d; }
    const float rs = rsqrtf(wave_sum(sq2) * (1.f / 1024.f) + 1e-5f);
    const float* m = MOD1 + sq * 3072;
#pragma unroll
    for (int i = 0; i < 4; ++i) {
      int col = i * 256 + lane * 4;
      float4 g = *(const float4*)(lg + col), b = *(const float4*)(lb + col), y;
      y.x = (v[i].x - mu) * rs * g.x + b.x; y.y = (v[i].y - mu) * rs * g.y + b.y; y.z = (v[i].z - mu) * rs * g.z + b.z; y.w = (v[i].w - mu) * rs * g.w + b.w;
      *(float4*)(xo + col) = y;
      if (layer == 0) {
        float4 sh = *(const float4*)(m + col), sc = *(const float4*)(m + 1024 + col);
        uint2 o; o.x = pack2(y.x * (1.f + sc.x) + sh.x, y.y * (1.f + sc.y) + sh.y); o.y = pack2(y.z * (1.f + sc.z) + sh.z, y.w * (1.f + sc.w) + sh.w);
        *(uint2*)(H + (size_t)row * D + col) = o;
      }
    }
  }
}

DEVI void unpack8(const uint4& a, float* o) {
  o[0] = __uint_as_float(a.x << 16); o[1] = __uint_as_float(a.x & 0xffff0000u); o[2] = __uint_as_float(a.y << 16); o[3] = __uint_as_float(a.y & 0xffff0000u);
  o[4] = __uint_as_float(a.z << 16); o[5] = __uint_as_float(a.z & 0xffff0000u); o[6] = __uint_as_float(a.w << 16); o[7] = __uint_as_float(a.w & 0xffff0000u);
}

DEVI void phase_combine0(const P& p) {
  const int lane = threadIdx.x & 63, gw = blockIdx.x * 8 + (threadIdx.x >> 6), nw = gridDim.x * 8;
  bf16_t* H = (bf16_t*)(p.ws + OFF_H);
  const bf16_t* OB = (const bf16_t*)p.out;
  const bf16_t* U = (const bf16_t*)(p.ws + OFF_U);
  const int c0 = lane * 16;
  const float* nw_ = c0 < 512 ? p.hgrn_norm + c0 : p.gla_norm + (c0 - 512);
  const int gcol = c0 < 512 ? 2048 + c0 : 3616 + (c0 - 512);
  float wn[16];
#pragma unroll
  for (int i = 0; i < 16; ++i) wn[i] = nw_[i];
  for (int row = gw; row < NTOK; row += nw) {
    float a[16], b[16], g[16];
    unpack8(*(const uint4*)(H + (size_t)row * D + c0), a); unpack8(*(const uint4*)(H + (size_t)row * D + c0 + 8), a + 8);
    unpack8(*(const uint4*)(OB + (size_t)row * D + c0), b); unpack8(*(const uint4*)(OB + (size_t)row * D + c0 + 8), b + 8);
    unpack8(*(const uint4*)(U + (size_t)row * EV_IN + gcol), g); unpack8(*(const uint4*)(U + (size_t)row * EV_IN + gcol + 8), g + 8);
    float ss = 0.f;
#pragma unroll
    for (int i = 0; i < 16; ++i) { a[i] += b[i]; ss += a[i] * a[i]; }
    ss += __shfl_xor(ss, 1); ss += __shfl_xor(ss, 2); ss += __shfl_xor(ss, 4);
    const float rs = rsqrtf(ss * (1.f / 128.f) + 1e-6f);
    uint4 o0, o1;
    float r[16];
#pragma unroll
    for (int i = 0; i < 16; ++i) r[i] = a[i] * rs * wn[i] * silu(g[i]);
    o0.x = pack2(r[0], r[1]); o0.y = pack2(r[2], r[3]); o0.z = pack2(r[4], r[5]); o0.w = pack2(r[6], r[7]);
    o1.x = pack2(r[8], r[9]); o1.y = pack2(r[10], r[11]); o1.z = pack2(r[12], r[13]); o1.w = pack2(r[14], r[15]);
    *(uint4*)(H + (size_t)row * D + c0) = o0; *(uint4*)(H + (size_t)row * D + c0 + 8) = o1;
  }
}

DEVI void phase_rwkv_post(const P& p) {
  const int lane = threadIdx.x & 63, gw = blockIdx.x * 8 + (threadIdx.x >> 6), nw = gridDim.x * 8;
  bf16_t* H = (bf16_t*)(p.ws + OFF_H);
  const bf16_t* OB = (const bf16_t*)(p.ws + OFF_OB1);
  const bf16_t* U = (const bf16_t*)(p.ws + OFF_U);
  const float* BON = (const float*)(p.ws + OFF_BONUS);
  const int c0 = lane * 8, hd_ = lane >> 3;
  float lw[8], lb[8], mv0[8], mv1[8], mg0[8], mg1[8];
#pragma unroll
  for (int i = 0; i < 8; ++i) {
    lw[i] = p.rwkv_ln_w[c0 + i]; lb[i] = p.rwkv_ln_b[c0 + i];
    mv0[i] = p.rwkv_mix[1024 + c0 + i]; mv1[i] = p.rwkv_mix[2144 + 1024 + c0 + i];
    mg0[i] = p.rwkv_mix[1632 + c0 + i]; mg1[i] = p.rwkv_mix[2144 + 1632 + c0 + i];
  }
  for (int row = gw; row < NTOK; row += nw) {
    int s = tok_seq(row), L, tb; seq_info(s, L, tb);
    const int pos = row - tb;
    float a[8], b[8], v[8], vp[8], vn[8], g[8], gp[8], gn[8];
    unpack8(*(const uint4*)(H + (size_t)row * D + 512 + c0), a);
    unpack8(*(const uint4*)(OB + (size_t)row * 512 + c0), b);
    const bf16_t* ur = U + (size_t)row * OD_IN;
    unpack8(*(const uint4*)(ur + 2304 + c0), v); unpack8(*(const uint4*)(ur + 2912 + c0), g);
    if (pos > 0) { unpack8(*(const uint4*)(ur - OD_IN + 2304 + c0), vp); unpack8(*(const uint4*)(ur - OD_IN + 2912 + c0), gp); }
    else {
#pragma unroll
      for (int i = 0; i < 8; ++i) { vp[i] = 0.f; gp[i] = 0.f; }
    }
    if (pos < L - 1) { unpack8(*(const uint4*)(ur + OD_IN + 2304 + c0), vn); unpack8(*(const uint4*)(ur + OD_IN + 2912 + c0), gn); }
    else {
#pragma unroll
      for (int i = 0; i < 8; ++i) { vn[i] = 0.f; gn[i] = 0.f; }
    }
    float sm = 0.f;
#pragma unroll
    for (int i = 0; i < 8; ++i) { a[i] += b[i]; sm += a[i]; }
    sm += __shfl_xor(sm, 1); sm += __shfl_xor(sm, 2); sm += __shfl_xor(sm, 4);
    const float mu = sm * (1.f / 64.f);
    float sq = 0.f;
#pragma unroll
    for (int i = 0; i < 8; ++i) { float d = a[i] - mu; sq += d * d; }
    sq += __shfl_xor(sq, 1); sq += __shfl_xor(sq, 2); sq += __shfl_xor(sq, 4);
    const float rs = rsqrtf(sq * (1.f / 64.f) + 64e-5f);
    const float bon = BON[(size_t)row * 8 + hd_];
    float r[8];
#pragma unroll
    for (int i = 0; i < 8; ++i) {
      float zv = v[i] + mv0[i] * (vp[i] - v[i]) + mv1[i] * (vn[i] - v[i]);
      float zg = g[i] + mg0[i] * (gp[i] - g[i]) + mg1[i] * (gn[i] - g[i]);
      r[i] = ((a[i] - mu) * rs * lw[i] + lb[i] + bon * zv) * silu(zg);
    }
    uint4 o; o.x = pack2(r[0], r[1]); o.y = pack2(r[2], r[3]); o.z = pack2(r[4], r[5]); o.w = pack2(r[6], r[7]);
    *(uint4*)(H + (size_t)row * D + 512 + c0) = o;
  }
}
#define MFMA16(a, b, c) __builtin_amdgcn_mfma_f32_16x16x32_bf16(a, b, c, 0, 0, 0)
template <int K, int MIX, int MODE>
DEVI void scan0_task(const P& p, char* smem, int s, int h, int dir, int n0, int nc, int sbase, int g) {
  constexpr int TQ = 512 / K, TS = 64 / TQ, KS = K + 8, NKT = K / 16, NKS = K / 32;
  bf16_t* QD = (bf16_t*)smem;
  bf16_t* KI = QD + 64 * KS;
  bf16_t* KET = KI + 64 * KS;
  bf16_t* VT = KET + K * 72;
  bf16_t* ATT = VT + 128 * 72;
  bf16_t* ST = ATT + 64 * 72;
  float* PART = (float*)(ST + 128 * KS);
  float* DEC = PART + TQ * K;
  const int tid = threadIdx.x, lane = tid & 63, w = tid >> 6, fr = lane & 15, fq = lane >> 4;
  int L, tb; seq_info(s, L, tb);
  const bf16_t* U = (const bf16_t*)(p.ws + OFF_U);
  bf16_t* OUT = dir ? (bf16_t*)p.out : (bf16_t*)(p.ws + OFF_H);
  const int ocol = MIX * 512 + h * 128;
  const int k = tid % K, tq = tid / K;
  const int vc2 = tid & 63, vq8 = tid >> 6;
  const int vbase = MIX == 0 ? 512 + h * 128 : 3072 + h * 128;
  float lbv = 0.f, bgk = 0.f; float wg[16];
  if (MIX == 0) { lbv = ((const float*)(p.ws + OFF_LB))[dir * 512 + h * 128 + k];
#pragma unroll
    for (int j = 0; j < 16; ++j) wg[j] = 0.f;
  } else {
#pragma unroll
    for (int j = 0; j < 16; ++j) wg[j] = p.gla_w_gk[(dir * 16 + j) * 256 + h * 64 + k];
    bgk = p.gla_b_gk[dir * 256 + h * 64 + k];
  }
  __syncthreads();
  f32x4 accS[NKT];
#pragma unroll
  for (int i = 0; i < NKT; ++i) accS[i] = (f32x4){0.f, 0.f, 0.f, 0.f};
  float dsum = 0.f;
  if (MODE == 0) {
    for (int j = 0; j < g; ++j) {
      const float* SL = (const float*)(p.ws + OFF_SLOC) + (size_t)(sbase + j) * 16384;
      const float* DT = (const float*)(p.ws + OFF_DTOT) + (size_t)(sbase + j) * 128;
#pragma unroll
      for (int tk = 0; tk < NKT; ++tk) {
        const float dcy = __expf(DT[tk * 16 + fr]);
#pragma unroll
        for (int e = 0; e < 4; ++e) accS[tk][e] = accS[tk][e] * dcy + SL[(w * 16 + fq * 4 + e) * 128 + tk * 16 + fr];
      }
    }
#pragma unroll
    for (int tk = 0; tk < NKT; ++tk)
#pragma unroll
      for (int e = 0; e < 4; ++e) ST[(w * 16 + fq * 4 + e) * KS + tk * 16 + fr] = f2bf(accS[tk][e]);
  }
  const int NE = n0 + nc;
  float* BLS = DEC + K;
  unsigned short rq[TS], rf[TS]; unsigned rv[8];
  uint4 rbl = make_uint4(0u, 0u, 0u, 0u);
  auto issue = [&](int n) {
#pragma unroll
    for (int i = 0; i < TS; ++i) {
      const int tt = n * 64 + tq * TS + i; const int pos = dir ? L - 1 - tt : tt;
      const bf16_t* row = U + (size_t)(tb + pos) * EV_IN;
      if (MIX == 0) { if (MODE == 0) rq[i] = row[h * 128 + k]; rf[i] = row[1024 + dir * 512 + h * 128 + k]; }
      else { if (MODE == 0) rq[i] = row[2560 + h * 64 + k]; rf[i] = row[2816 + h * 64 + k]; }
    }
#pragma unroll
    for (int i = 0; i < 8; ++i) {
      const int tt = n * 64 + vq8 * 8 + i; const int pos = dir ? L - 1 - tt : tt;
      rv[i] = *(const unsigned*)(U + (size_t)(tb + pos) * EV_IN + vbase + 2 * vc2);
    }
    if (MIX == 1 && tid < 128) {
      const int tt = n * 64 + (tid >> 1); const int pos = dir ? L - 1 - tt : tt;
      rbl = *(const uint4*)(U + (size_t)(tb + pos) * EV_IN + 3584 + dir * 16 + (tid & 1) * 8);
    }
  };
  issue(n0);
  for (int n = n0; n < NE; ++n) {
    float cb[TS];
    float run = 0.f;
    if (MIX == 1) {
      if (tid < 128) { float bv[8]; unpack8(rbl, bv); float* d = BLS + (tid >> 1) * 16 + (tid & 1) * 8;
#pragma unroll
        for (int j = 0; j < 8; ++j) d[j] = bv[j]; }
      __syncthreads();
    }
#pragma unroll
    for (int i = 0; i < TS; ++i) {
      float lf;
      if (MIX == 0) {
        lf = __logf(1.f - bf2f(rf[i]));
      } else {
        const float4* bl = (const float4*)(BLS + (tq * TS + i) * 16);
        float z = bgk;
#pragma unroll
        for (int j = 0; j < 4; ++j) { float4 b4 = bl[j]; z += b4.x * wg[4 * j] + b4.y * wg[4 * j + 1] + b4.z * wg[4 * j + 2] + b4.w * wg[4 * j + 3]; }
        lf = (fminf(z, 0.f) - __logf(1.f + __expf(-fabsf(z)))) * (1.f / 16.f);
      }
      run += lf; cb[i] = run;
    }
    PART[tq * K + k] = run;
    {
      uint4 lo, hi;
      lo.x = (rv[0] & 0xffffu) | (rv[1] << 16); lo.y = (rv[2] & 0xffffu) | (rv[3] << 16); lo.z = (rv[4] & 0xffffu) | (rv[5] << 16); lo.w = (rv[6] & 0xffffu) | (rv[7] << 16);
      hi.x = (rv[0] >> 16) | (rv[1] & 0xffff0000u); hi.y = (rv[2] >> 16) | (rv[3] & 0xffff0000u); hi.z = (rv[4] >> 16) | (rv[5] & 0xffff0000u); hi.w = (rv[6] >> 16) | (rv[7] & 0xffff0000u);
      *(uint4*)(VT + (2 * vc2) * 72 + vq8 * 8) = lo; *(uint4*)(VT + (2 * vc2 + 1) * 72 + vq8 * 8) = hi;
    }
    __syncthreads();
    float pre = 0.f, tot = 0.f;
#pragma unroll
    for (int j = 0; j < TQ; ++j) { float v = PART[j * K + k]; tot += v; if (j < tq) pre += v; }
    const float etot = __expf(tot);
    if (tq == 0) { DEC[k] = etot; dsum += tot; }
    {
      unsigned pk[TS / 2];
#pragma unroll
      for (int i = 0; i < TS; i += 2) {
        const int t0 = tq * TS + i;
        const float k0 = bf2f(rf[i]), k1 = bf2f(rf[i + 1]);
        const float e0 = __expf(pre + cb[i]), e1 = __expf(pre + cb[i + 1]);
        const float ki0 = k0 * frcp(e0), ki1 = k1 * frcp(e1);
        if (MODE == 0) {
          QD[t0 * KS + k] = f2bf(bf2f(rq[i]) * e0); QD[(t0 + 1) * KS + k] = f2bf(bf2f(rq[i + 1]) * e1);
          KI[t0 * KS + k] = f2bf(ki0); KI[(t0 + 1) * KS + k] = f2bf(ki1);
        }
        pk[i / 2] = pack2(ki0 * etot, ki1 * etot);
      }
      uint4* dst = (uint4*)(KET + k * 72 + tq * TS);
      dst[0] = make_uint4(pk[0], pk[1], pk[2], pk[3]);
      if (TS == 16) dst[1] = make_uint4(pk[TS / 2 - 4], pk[TS / 2 - 3], pk[TS / 2 - 2], pk[TS / 2 - 1]);
    }
    if (n + 1 < NE) issue(n + 1);
    __syncthreads();
    if (MODE == 0) {
      const int ti = w >> 1;
#pragma unroll
      for (int c2 = 0; c2 < 2; ++c2) {
        const int tj = (w & 1) * 2 + c2;
        f32x4 a = {0.f, 0.f, 0.f, 0.f};
        if (tj <= ti) {
#pragma unroll
          for (int ks = 0; ks < NKS; ++ks) {
            bf16x8 kf = *(const bf16x8*)(KI + (tj * 16 + fr) * KS + ks * 32 + fq * 8);
            bf16x8 qf = *(const bf16x8*)(QD + (ti * 16 + fr) * KS + ks * 32 + fq * 8);
            a = MFMA16(kf, qf, a);
          }
        }
        const int i = ti * 16 + fr, j0 = tj * 16 + fq * 4;
        uint2 v; v.x = pack2(j0 <= i ? a[0] : 0.f, j0 + 1 <= i ? a[1] : 0.f); v.y = pack2(j0 + 2 <= i ? a[2] : 0.f, j0 + 3 <= i ? a[3] : 0.f);
        *(uint2*)(ATT + i * 72 + j0) = v;
      }
    }
    if (MODE == 0) __syncthreads();
    {
      const int tv = w;
      bf16x8 vf[2], sf[NKS];
#pragma unroll
      for (int ks = 0; ks < 2; ++ks) vf[ks] = *(const bf16x8*)(VT + (tv * 16 + fr) * 72 + ks * 32 + fq * 8);
      if (MODE == 0) {
#pragma unroll
      for (int ks = 0; ks < NKS; ++ks) sf[ks] = *(const bf16x8*)(ST + (tv * 16 + fr) * KS + ks * 32 + fq * 8);
#pragma unroll
      for (int ti = 0; ti < 4; ++ti) {
        f32x4 o = {0.f, 0.f, 0.f, 0.f};
#pragma unroll
        for (int ks = 0; ks < 2; ++ks) { bf16x8 af = *(const bf16x8*)(ATT + (ti * 16 + fr) * 72 + ks * 32 + fq * 8); o = MFMA16(vf[ks], af, o); }
#pragma unroll
        for (int ks = 0; ks < NKS; ++ks) { bf16x8 qf = *(const bf16x8*)(QD + (ti * 16 + fr) * KS + ks * 32 + fq * 8); o = MFMA16(sf[ks], qf, o); }
        const int tt = n * 64 + ti * 16 + fr; const int pos = dir ? L - 1 - tt : tt;
        uint2 ov; ov.x = pack2(o[0], o[1]); ov.y = pack2(o[2], o[3]);
        *(uint2*)(OUT + (size_t)(tb + pos) * D + ocol + tv * 16 + fq * 4) = ov;
      }
      }
#pragma unroll
      for (int tk = 0; tk < NKT; ++tk) {
        const float dc = DEC[tk * 16 + fr];
        f32x4 a = accS[tk]; a[0] *= dc; a[1] *= dc; a[2] *= dc; a[3] *= dc;
#pragma unroll
        for (int ks = 0; ks < 2; ++ks) { bf16x8 kf = *(const bf16x8*)(KET + (tk * 16 + fr) * 72 + ks * 32 + fq * 8); a = MFMA16(vf[ks], kf, a); }
        accS[tk] = a;
      }
    }
    __syncthreads();
    if (MODE == 0) {
      const int tv = w;
#pragma unroll
      for (int tk = 0; tk < NKT; ++tk)
#pragma unroll
        for (int e = 0; e < 4; ++e) ST[(tv * 16 + fq * 4 + e) * KS + tk * 16 + fr] = f2bf(accS[tk][e]);
    }
  }
  if (MODE == 1) {
    float* SL = (float*)(p.ws + OFF_SLOC) + (size_t)(sbase + g) * 16384;
#pragma unroll
    for (int tk = 0; tk < NKT; ++tk)
#pragma unroll
      for (int e = 0; e < 4; ++e) SL[(w * 16 + fq * 4 + e) * 128 + tk * 16 + fr] = accS[tk][e];
    if (tq == 0) ((float*)(p.ws + OFF_DTOT))[(size_t)(sbase + g) * 128 + k] = dsum;
  }
  __syncthreads();
}
template <int MODE, int DIR>
DEVI void rwkv_task(const P& p, char* smem, int s, int h, int n0, int nc, int sbase, int g) {
  constexpr int dir = DIR;
  bf16_t* QH = (bf16_t*)smem;
  bf16_t* RH = QH + 4 * 16 * 72;
  bf16_t* BT = RH + 4 * 16 * 72;
  bf16_t* KT = BT + 4 * 16 * 72;
  bf16_t* BKE = KT + 4 * 16 * 72;
  bf16_t* VB = BKE + 4 * 64 * 40;
  float* GT = (float*)(VB + 4 * 64 * 24);
  float* AU = GT + 4 * 64;
  bf16_t* NT = (bf16_t*)(AU + 4 * 256);
  float* OO = (float*)(NT + 4 * 256);
  float* SCAL = OO + 64 * 64;
  bf16_t* LOW = (bf16_t*)(SCAL + 256);
  const int tid = threadIdx.x, lane = tid & 63, w = tid >> 6, fr = lane & 15, fq = lane >> 4;
  int L, tb; seq_info(s, L, tb);
  const bf16_t* U = (const bf16_t*)(p.ws + OFF_U);
  const float* mix0 = p.rwkv_mix; const float* mix1 = p.rwkv_mix + 2144;
  const int hc0 = h * 64;
  const int tt = w >> 1;
  float* CT = (float*)(LOW + 64 * 72);
  bf16_t* W2T = (bf16_t*)(CT + 13 * 64);
  bf16_t* A2T = W2T + 64 * 40;
  __syncthreads();
  if (tid < 64) {
    const int c = hc0 + tid;
    CT[0 * 64 + tid] = p.rwkv_w0[dir * 512 + c]; CT[1 * 64 + tid] = p.rwkv_a0[c]; CT[2 * 64 + tid] = p.rwkv_k_k[c]; CT[3 * 64 + tid] = p.rwkv_k_a[c]; CT[4 * 64 + tid] = p.rwkv_r_k[c];
    { const int lcol_ = tid < 32 ? 2816 + dir * 32 + tid : 2880 + (tid - 32); CT[11 * 64 + tid] = mix0[lcol_ - 1280]; CT[12 * 64 + tid] = mix1[lcol_ - 1280]; }
    CT[5 * 64 + tid] = mix0[c]; CT[6 * 64 + tid] = mix1[c]; CT[7 * 64 + tid] = mix0[512 + c]; CT[8 * 64 + tid] = mix1[512 + c]; CT[9 * 64 + tid] = mix0[1024 + c]; CT[10 * 64 + tid] = mix1[1024 + c];
  }
  for (int i = tid; i < 64 * 32; i += NTHR) {
    const int j = i >> 6, c = i & 63;
    W2T[c * 40 + j] = f2bf(p.rwkv_w_w2[(size_t)(dir * 32 + j) * 512 + hc0 + c]);
    A2T[c * 40 + j] = f2bf(p.rwkv_a_w2[(size_t)j * 512 + hc0 + c]);
  }
  const int lc = tid & 63, tg = tid >> 6;
  f32x4 accS[4];
#pragma unroll
  for (int i = 0; i < 4; ++i) accS[i] = (f32x4){0.f, 0.f, 0.f, 0.f};
  const int wl = w & 3;
  if (MODE == 1 && w >= 4) {
#pragma unroll
    for (int tk = 0; tk < 4; ++tk)
#pragma unroll
      for (int e = 0; e < 4; ++e) accS[tk][e] = (tk * 16 + fq * 4 + e == wl * 16 + fr) ? 1.f : 0.f;
  }
  bf16_t* OUTB = dir ? (bf16_t*)(p.ws + OFF_OB1) : (bf16_t*)(p.ws + OFF_H);
  const int ostride = dir ? 512 : 1024, ocol = dir ? hc0 : 512 + hc0;
  float* BON = (float*)(p.ws + OFF_BONUS);
  const int NC = L / 64;
  bf16_t* RAW = A2T + 64 * 40;
  uint4 pre[5];
  auto issue = [&](int n) {
    const int Pb = dir ? L - 64 * (n + 1) : 64 * n;
    const bf16_t* ub = U + (size_t)(tb + Pb) * OD_IN;
#pragma unroll
    for (int j = 0; j < 5; ++j) {
      const int ui = threadIdx.x + j * NTHR, row = ui >> 5, sg = ui & 31;
      const int col = sg < 8 ? 1280 + hc0 + sg * 8 : sg < 16 ? 1792 + hc0 + (sg - 8) * 8 : sg < 24 ? 2304 + hc0 + (sg - 16) * 8 : sg < 28 ? 2816 + dir * 32 + (sg - 24) * 8 : 2880 + (sg - 28) * 8;
      const int pa = Pb + row - 1;
      pre[j] = make_uint4(0u, 0u, 0u, 0u);
      if (row < 66 && pa >= 0 && pa < L) pre[j] = *(const uint4*)(ub + (row - 1) * OD_IN + col);
    }
  };
  if (MODE == 0 && g > 0) {
    float* Sb = OO; float* Mb = (float*)RAW;
    const float* NM = (const float*)(p.ws + OFF_SLOC);
    const int fv = tid >> 3, fk = (tid & 7) * 8;
    __syncthreads();
    { const float* N0 = NM + (size_t)sbase * 8192 + fv * 64 + fk; *(float4*)(Sb + fv * 64 + fk) = *(const float4*)N0; *(float4*)(Sb + fv * 64 + fk + 4) = *(const float4*)(N0 + 4); }
    for (int j = 1; j < g; ++j) {
      const float* Nj = NM + (size_t)(sbase + j) * 8192; const float* Mj = Nj + 4096;
      *(float4*)(Mb + fv * 64 + fk) = *(const float4*)(Mj + fv * 64 + fk); *(float4*)(Mb + fv * 64 + fk + 4) = *(const float4*)(Mj + fv * 64 + fk + 4);
      float acc[8];
      { const float4 a0 = *(const float4*)(Nj + fv * 64 + fk), a1 = *(const float4*)(Nj + fv * 64 + fk + 4); acc[0] = a0.x; acc[1] = a0.y; acc[2] = a0.z; acc[3] = a0.w; acc[4] = a1.x; acc[5] = a1.y; acc[6] = a1.z; acc[7] = a1.w; }
      __syncthreads();
      for (int kp = 0; kp < 64; ++kp) {
        const float sv = Sb[fv * 64 + kp];
        const float4 m0 = *(const float4*)(Mb + kp * 64 + fk), m1 = *(const float4*)(Mb + kp * 64 + fk + 4);
        acc[0] += sv * m0.x; acc[1] += sv * m0.y; acc[2] += sv * m0.z; acc[3] += sv * m0.w; acc[4] += sv * m1.x; acc[5] += sv * m1.y; acc[6] += sv * m1.z; acc[7] += sv * m1.w;
      }
      __syncthreads();
      *(float4*)(Sb + fv * 64 + fk) = make_float4(acc[0], acc[1], acc[2], acc[3]); *(float4*)(Sb + fv * 64 + fk + 4) = make_float4(acc[4], acc[5], acc[6], acc[7]);
    }
    __syncthreads();
    if (w < 4) {
#pragma unroll
      for (int tk = 0; tk < 4; ++tk) { const float4 t4 = *(const float4*)(Sb + (w * 16 + fr) * 64 + tk * 16 + fq * 4); accS[tk][0] = t4.x; accS[tk][1] = t4.y; accS[tk][2] = t4.z; accS[tk][3] = t4.w; }
    }
    __syncthreads();
  }
  const int NE = n0 + nc;
  issue(n0);
  if (tid < 256) SCAL[tid] = 0.f;
  __syncthreads();
  for (int n = n0; n < NE; ++n) {
    const int Pbase = dir ? L - 64 * (n + 1) : 64 * n;
    int tid; asm volatile("v_mov_b32 %0, %1" : "=v"(tid) : "v"(threadIdx.x));
    const int lane = tid & 63, w = tid >> 6, fr = lane & 15, fq = lane >> 4, tt = w >> 1, lc = tid & 63, tg = tid >> 6, wl = w & 3;
#pragma unroll
    for (int j = 0; j < 5; ++j) { const int ui = tid + j * NTHR; if (ui < 66 * 32) *(uint4*)(RAW + (ui >> 5) * 264 + (ui & 31) * 8) = pre[j]; }
    __syncthreads();
    {
      float u[10];
      const float lm0 = CT[11 * 64 + lc], lm1 = CT[12 * 64 + lc];
#pragma unroll
      for (int i = 0; i < 10; ++i) u[i] = bf2f(RAW[(tg * 8 + i) * 264 + 192 + lc]);
#pragma unroll
      for (int i = 0; i < 8; ++i) {
        float z = u[i + 1] + lm0 * (u[i] - u[i + 1]) + lm1 * (u[i + 2] - u[i + 1]);
        if (lc < 32) z = ftanh(z);
        const int pc = tg * 8 + i, t = dir ? 63 - pc : pc;
        LOW[t * 72 + lc] = f2bf(z);
      }
    }
    const int tl = tt * 16 + fq * 4;
    const int pcl = dir ? 63 - (tl + 3) : tl;
    {
      float nsq[4] = {0.f, 0.f, 0.f, 0.f};
#pragma unroll
      for (int c2 = 0; c2 < 2; ++c2) {
        const int cl_ = ((w & 1) * 2 + c2) * 16 + fr;
        const float kkc_ = CT[128 + cl_], m0k_ = CT[448 + cl_], m1k_ = CT[512 + cl_];
        float uk[6];
#pragma unroll
        for (int i = 0; i < 6; ++i) uk[i] = bf2f(RAW[(pcl + i) * 264 + 64 + cl_]);
#pragma unroll
        for (int e = 0; e < 4; ++e) {
          const float ukc = dir ? uk[4 - e] : uk[1 + e], ukm = dir ? uk[3 - e] : uk[e], ukp = dir ? uk[5 - e] : uk[2 + e];
          const float kkraw = (ukc + m0k_ * (ukm - ukc) + m1k_ * (ukp - ukc)) * kkc_;
          nsq[e] += kkraw * kkraw;
        }
      }
      reduce4_row16(nsq[0], nsq[1], nsq[2], nsq[3]);
      if (fr == 0) {
#pragma unroll
        for (int e = 0; e < 4; ++e) atomicAdd(&SCAL[(tl + e) * 4 + 0], nsq[e]);
      }
    }
    __syncthreads();
    {
      const bf16x8 aW = *(const bf16x8*)(LOW + (tt * 16 + fr) * 72 + fq * 8);
      const bf16x8 aA = *(const bf16x8*)(LOW + (tt * 16 + fr) * 72 + 32 + fq * 8);
      float sbo[4] = {0.f, 0.f, 0.f, 0.f};
      float inv4[4];
#pragma unroll
      for (int e = 0; e < 4; ++e) inv4[e] = rsqrtf(fmaxf(SCAL[(tl + e) * 4], 1e-24f));
#pragma unroll
      for (int c2 = 0; c2 < 2; ++c2) {
        f32x4 z4 = {0.f, 0.f, 0.f, 0.f};
        const int cl = ((w & 1) * 2 + c2) * 16 + fr;
        f32x4 wd = MFMA16(aW, *(const bf16x8*)(W2T + cl * 40 + fq * 8), z4);
        f32x4 ad = MFMA16(aA, *(const bf16x8*)(A2T + cl * 40 + fq * 8), z4);
        float ur[6], uk[6], uv[6];
        const float w0c_ = CT[cl], a0c_ = CT[64 + cl], kkc_ = CT[128 + cl], kac_ = CT[192 + cl], rkc_ = CT[256 + cl];
        const float m0r_ = CT[320 + cl], m1r_ = CT[384 + cl], m0k_ = CT[448 + cl], m1k_ = CT[512 + cl], m0v_ = CT[576 + cl], m1v_ = CT[640 + cl];
#pragma unroll
        for (int i = 0; i < 6; ++i) { const bf16_t* rr = RAW + (pcl + i) * 264 + cl; ur[i] = bf2f(rr[0]); uk[i] = bf2f(rr[64]); uv[i] = bf2f(rr[128]); }
        float zr[4], wdc[4], kmv[4], zv4[4], kk4[4], b4[4];
#pragma unroll
        for (int e = 0; e < 4; ++e) {
          const float urc = dir ? ur[4 - e] : ur[1 + e], urm = dir ? ur[3 - e] : ur[e], urp = dir ? ur[5 - e] : ur[2 + e];
          const float ukc = dir ? uk[4 - e] : uk[1 + e], ukm = dir ? uk[3 - e] : uk[e], ukp = dir ? uk[5 - e] : uk[2 + e];
          const float uvc = dir ? uv[4 - e] : uv[1 + e], uvm = dir ? uv[3 - e] : uv[e], uvp = dir ? uv[5 - e] : uv[2 + e];
          const float r_ = urc + m0r_ * (urm - urc) + m1r_ * (urp - urc);
          const float k_ = ukc + m0k_ * (ukm - ukc) + m1k_ * (ukp - ukc);
          const float v_ = uvc + m0v_ * (uvm - uvc) + m1v_ * (uvp - uvc);
          const float a_ = sigm(a0c_ + ad[e]);
          zr[e] = r_; wdc[e] = __expf(-0.6065306597126334f * sigm(w0c_ + wd[e])); kmv[e] = k_ * (1.f + (a_ - 1.f) * kac_); zv4[e] = v_;
          kk4[e] = k_ * kkc_ * inv4[e]; b4[e] = kk4[e] * a_;
          sbo[e] += r_ * kmv[e] * rkc_;
        }
        float pr[4];
        pr[0] = wdc[0]; pr[1] = pr[0] * wdc[1]; pr[2] = pr[1] * wdc[2]; pr[3] = pr[2] * wdc[3];
        const float x = pr[3];
        float y = __shfl_up(x, 16); y = fq >= 1 ? x * y : x;
        float z = __shfl_up(y, 32); z = fq >= 2 ? y * z : y;
        float ex = __shfl_up(z, 16); ex = fq >= 1 ? ex : 1.f;
        const float gtot = __shfl(z, 48 + fr);
        float be[4], ke[4];
#pragma unroll
        for (int e = 0; e < 4; ++e) {
          const float Gt = ex * pr[e], Gm = e ? ex * pr[e > 0 ? e - 1 : 0] : ex;
          const float ig = frcp(Gt);
          const int ro = (tt * 16 + fq * 4 + e) * 72 + cl;
          QH[ro] = f2bf(Gm * kk4[e]); RH[ro] = f2bf(Gt * zr[e]);
          const float btl = b4[e] * ig, ktl = kmv[e] * ig;
          BT[ro] = f2bf(btl); KT[ro] = f2bf(ktl);
          be[e] = btl * gtot; ke[e] = ktl * gtot;
        }
        *(uint4*)(BKE + (tt * 64 + cl) * 40 + fq * 8) = make_uint4(pack2(be[0], be[1]), pack2(be[2], be[3]), pack2(ke[0], ke[1]), pack2(ke[2], ke[3]));
        *(uint2*)(VB + (tt * 64 + cl) * 24 + fq * 4) = make_uint2(pack2(zv4[0], zv4[1]), pack2(zv4[2], zv4[3]));
        if (fq == 0) GT[tt * 64 + cl] = gtot;
      }
      reduce4_row16(sbo[0], sbo[1], sbo[2], sbo[3]);
      if (fr == 0) {
#pragma unroll
        for (int e = 0; e < 4; ++e) atomicAdd(&SCAL[(tl + e) * 4 + 3], sbo[e]);
      }
    }
    __syncthreads();
    if (MODE == 0 && dir == 0 && tid < 64) BON[(size_t)(tb + Pbase + tid) * 8 + h] = SCAL[tid * 4 + 3];
#ifndef NO_PD
    int oz; asm volatile("v_mov_b32 %0, 0" : "=v"(oz));
    if (w >= 4) {
      const int bt = w - 4;
      f32x4 au = {0.f, 0.f, 0.f, 0.f};
#pragma unroll
      for (int ks = 0; ks < 2; ++ks) {
        const bf16x8 af = *(const bf16x8*)(BT + (bt * 16 + fr) * 72 + ks * 32 + fq * 8);
        const bf16x8 qf = *(const bf16x8*)(QH + (bt * 16 + fr) * 72 + ks * 32 + fq * 8);
        au = MFMA16(af, qf, au);
      }
#pragma unroll
      for (int e = 0; e < 4; ++e) AU[(bt * 16 + fq * 4 + e) * 16 + fr] = au[e];
      asm volatile("s_waitcnt lgkmcnt(0)" ::: "memory");
      const int ii = (lane & 15) + oz;
      float Y[16];
#pragma unroll
      for (int j = 0; j < 16; ++j) Y[j] = (j == ii) ? 1.f : 0.f;
#pragma unroll
      for (int k = 0; k < 15; ++k) {
        const float4* rowp = (const float4*)(AU + (bt * 16 + k) * 16);
        float rv[16];
#pragma unroll
        for (int q = 0; q < 4; ++q) { if (q * 4 + 3 > k) { const float4 t4 = rowp[q]; rv[q * 4] = t4.x; rv[q * 4 + 1] = t4.y; rv[q * 4 + 2] = t4.z; rv[q * 4 + 3] = t4.w; } }
#pragma unroll
        for (int j = k + 1; j < 16; ++j) Y[j] -= rv[j] * Y[k];
        if ((k & 3) == 3) __builtin_amdgcn_sched_barrier(0);
      }
      if (fq == 0) {
#pragma unroll
        for (int j = 0; j < 16; ++j) NT[(bt * 16 + j) * 16 + ii] = f2bf(-Y[j]);
      }
    }
#endif
    __syncthreads();
    if (tid < 256) SCAL[tid] = 0.f;
    if (n + 1 < NE) issue(n + 1);
#ifndef NO_PE
    if (w < 4 || MODE == 1) {
#pragma unroll
      for (int bt = 0; bt < 4; ++bt) {
        const bf16_t* qh = QH + (bt * 16 + fr) * 72; const bf16_t* rh = RH + (bt * 16 + fr) * 72;
        const bf16_t* bth = BT + (bt * 16 + fr) * 72; const bf16_t* kth = KT + (bt * 16 + fr) * 72;
        f32x4 avk = {0.f, 0.f, 0.f, 0.f}, br = avk, kr = avk;
#pragma unroll
        for (int ks = 0; ks < 2; ++ks) {
          const bf16x8 ktf = *(const bf16x8*)(kth + ks * 32 + fq * 8), btf = *(const bf16x8*)(bth + ks * 32 + fq * 8);
          const bf16x8 qf = *(const bf16x8*)(qh + ks * 32 + fq * 8), rf = *(const bf16x8*)(rh + ks * 32 + fq * 8);
          avk = MFMA16(ktf, qf, avk); br = MFMA16(btf, rf, br); kr = MFMA16(ktf, rf, kr);
        }
        bf16x8 sp[2], qa[2], ra[2];
#pragma unroll
        for (int m = 0; m < 2; ++m) {
#pragma unroll
          for (int e = 0; e < 4; ++e) { sp[m][e] = (short)f2bf(accS[2 * m][e]); sp[m][4 + e] = (short)f2bf(accS[2 * m + 1][e]); }
          const uint2 q0 = *(const uint2*)(qh + 32 * m + fq * 4), q1 = *(const uint2*)(qh + 32 * m + 16 + fq * 4);
          const uint2 r0 = *(const uint2*)(rh + 32 * m + fq * 4), r1 = *(const uint2*)(rh + 32 * m + 16 + fq * 4);
          qa[m] = __builtin_bit_cast(bf16x8, make_uint4(q0.x, q0.y, q1.x, q1.y));
          ra[m] = __builtin_bit_cast(bf16x8, make_uint4(r0.x, r0.y, r1.x, r1.y));
        }
        uint2 vv = *(const uint2*)(VB + (bt * 64 + wl * 16 + fr) * 24 + fq * 4);
        if (MODE == 1 && w >= 4) vv = make_uint2(0u, 0u);
        const uint2 ntv = *(const uint2*)(NT + (bt * 16 + fr) * 16 + fq * 4);
        const int i0 = fq * 4;
        const bf16x8 v_op = __builtin_bit_cast(bf16x8, make_uint4(0u, 0u, vv.x, vv.y));
        const bf16x8 avk_op = __builtin_bit_cast(bf16x8, make_uint4(0u, 0u, pack2(i0 < fr ? avk[0] : 0.f, i0 + 1 < fr ? avk[1] : 0.f), pack2(i0 + 2 < fr ? avk[2] : 0.f, i0 + 3 < fr ? avk[3] : 0.f)));
        f32x4 z4 = {0.f, 0.f, 0.f, 0.f};
        f32x4 W = MFMA16(qa[0], sp[0], z4); W = MFMA16(qa[1], sp[1], W); W = MFMA16(avk_op, v_op, W);
        const bf16x8 nt_op = __builtin_bit_cast(bf16x8, make_uint4(ntv.x, ntv.y, 0u, 0u));
        const bf16x8 w_op = __builtin_bit_cast(bf16x8, make_uint4(pack2(W[0], W[1]), pack2(W[2], W[3]), 0u, 0u));
        const f32x4 Uu = MFMA16(nt_op, w_op, z4);
        const bf16x8 uv_op = __builtin_bit_cast(bf16x8, make_uint4(pack2(Uu[0], Uu[1]), pack2(Uu[2], Uu[3]), vv.x, vv.y));
        const bf16x8 brkr_op = __builtin_bit_cast(bf16x8, make_uint4(pack2(i0 <= fr ? br[0] : 0.f, i0 + 1 <= fr ? br[1] : 0.f), pack2(i0 + 2 <= fr ? br[2] : 0.f, i0 + 3 <= fr ? br[3] : 0.f),
                                                                      pack2(i0 <= fr ? kr[0] : 0.f, i0 + 1 <= fr ? kr[1] : 0.f), pack2(i0 + 2 <= fr ? kr[2] : 0.f, i0 + 3 <= fr ? kr[3] : 0.f)));
        f32x4 O = MFMA16(ra[0], sp[0], z4); O = MFMA16(ra[1], sp[1], O); O = MFMA16(brkr_op, uv_op, O);
        if (MODE == 0) {
#pragma unroll
          for (int e = 0; e < 4; ++e) OO[(bt * 16 + fq * 4 + e) * 64 + w * 16 + fr] = O[e];
        }
#pragma unroll
        for (int tk = 0; tk < 4; ++tk) {
          const float4 g4 = *(const float4*)(GT + bt * 64 + tk * 16 + fq * 4);
          f32x4 a = accS[tk]; a[0] *= g4.x; a[1] *= g4.y; a[2] *= g4.z; a[3] *= g4.w;
          const bf16x8 bk = *(const bf16x8*)(BKE + (bt * 64 + tk * 16 + fr) * 40 + fq * 8);
          accS[tk] = MFMA16(bk, uv_op, a);
        }
      }
    }
#endif
    __syncthreads();
    if (MODE == 0) {
      const int t = tid >> 3, r8 = (tid & 7) * 8;
      const int pc = dir ? 63 - t : t;
      const float* src = OO + t * 64 + r8;
      uint4 o; o.x = pack2(src[0], src[1]); o.y = pack2(src[2], src[3]); o.z = pack2(src[4], src[5]); o.w = pack2(src[6], src[7]);
      *(uint4*)(OUTB + (size_t)(tb + Pbase + pc) * ostride + ocol + r8) = o;
    }
  }
  if (MODE == 1) {
    float* dst = (float*)(p.ws + OFF_SLOC) + (size_t)(sbase + g) * 8192 + (w >= 4 ? 4096 : 0);
#pragma unroll
    for (int tk = 0; tk < 4; ++tk) *(float4*)(dst + (wl * 16 + fr) * 64 + tk * 16 + fq * 4) = make_float4(accS[tk][0], accS[tk][1], accS[tk][2], accS[tk][3]);
  }
  __syncthreads();
}

DEVI void attn_task(const P& p, char* smem, int blk, int g) {
  bf16_t* KR = (bf16_t*)smem;
  bf16_t* VT = KR + 384 * 72;
  int tid; asm volatile("v_mov_b32 %0, %1" : "=v"(tid) : "v"(threadIdx.x));
  const int lane = tid & 63, w = tid >> 6, fr = lane & 15, fq = lane >> 4;
  const int tok0 = blk * 128, s = tok_seq(tok0);
  int L, tb; seq_info(s, L, tb);
  const int nb = (tok0 - tb) >> 7;
  const float2* ROPE = (const float2*)(p.ws + OFF_ROPE);
  const bf16_t* U = (const bf16_t*)(p.ws + OFF_U);
  bf16_t* H = (bf16_t*)(p.ws + OFF_H);
  __syncthreads();
#pragma unroll 8
  for (int it = 0; it < 24; ++it) {
    const int i = tid + it * NTHR;
    const int key = i >> 5, d = i & 31, kpos = (nb - 1) * 128 + key;
    const bool ok = kpos >= 0 && kpos < L;
    const int kc = kpos < 0 ? 0 : (kpos >= L ? L - 1 : kpos);
    const bf16_t* row = U + (size_t)(tb + kc) * OD_IN + 512 + g * 64;
    const float a = bf2f(row[d]), b = bf2f(row[d + 32]); const float2 cs = ROPE[kc * 32 + d];
    const float k1 = ok ? a * cs.x - b * cs.y : 0.f, k2 = ok ? b * cs.x + a * cs.y : 0.f;
    KR[key * 72 + d] = f2bf(k1); KR[key * 72 + d + 32] = f2bf(k2);
  }
#pragma unroll 16
  for (int it = 0; it < 48; ++it) {
    const int i = tid + it * NTHR;
    const int key = i >> 6, d = i & 63, kpos = (nb - 1) * 128 + key;
    const bool ok = kpos >= 0 && kpos < L;
    const int kc = kpos < 0 ? 0 : (kpos >= L ? L - 1 : kpos);
    const bf16_t v = U[(size_t)(tb + kc) * OD_IN + 640 + g * 64 + d];
    VT[d * 392 + key] = ok ? v : (bf16_t)0;
  }
  __syncthreads();
  const int hq = g * 4 + (w >> 1);
  const float sink = p.swa_sink[hq];
  uint4 rqa, rqb; float4 rcs[4];
  auto issue_q = [&](int mt_) {
    const int qp = nb * 128 + (w & 1) * 64 + mt_ * 16 + fr;
    const bf16_t* row = U + ((size_t)tb + qp) * OD_IN + hq * 64;
    rqa = *(const uint4*)(row + fq * 8); rqb = *(const uint4*)(row + 32 + fq * 8);
    const float4* rp = (const float4*)(ROPE + qp * 32 + fq * 8);
    rcs[0] = rp[0]; rcs[1] = rp[1]; rcs[2] = rp[2]; rcs[3] = rp[3];
  };
  issue_q(0);
  for (int mt = 0; mt < 4; ++mt) {
    const int qloc = (w & 1) * 64 + mt * 16 + fr, qpos = nb * 128 + qloc;
    const size_t tokq = (size_t)tb + qpos;
    bf16x8 qf[2];
    {
      float qa[8], qb[8]; unpack8(rqa, qa); unpack8(rqb, qb);
#pragma unroll
      for (int j = 0; j < 4; ++j) {
        const float4 cs = rcs[j];
        qf[0][2 * j] = (short)f2bf((qa[2 * j] * cs.x - qb[2 * j] * cs.y) * 0.125f); qf[1][2 * j] = (short)f2bf((qb[2 * j] * cs.x + qa[2 * j] * cs.y) * 0.125f);
        qf[0][2 * j + 1] = (short)f2bf((qa[2 * j + 1] * cs.z - qb[2 * j + 1] * cs.w) * 0.125f); qf[1][2 * j + 1] = (short)f2bf((qb[2 * j + 1] * cs.z + qa[2 * j + 1] * cs.w) * 0.125f);
      }
    }
    if (mt < 3) issue_q(mt + 1);
    const int q16 = (w & 1) * 4 + mt;
    f32x4 sc[17];
#pragma unroll
    for (int i = 0; i < 17; ++i) {
      const int nt = q16 + i;
      f32x4 a = {0.f, 0.f, 0.f, 0.f};
#pragma unroll
      for (int ks = 0; ks < 2; ++ks) { bf16x8 kf = *(const bf16x8*)(KR + (nt * 16 + fr) * 72 + ks * 32 + fq * 8); a = MFMA16(kf, qf[ks], a); }
      sc[i] = a;
    }
    float m = sink;
#pragma unroll
    for (int i = 0; i < 17; ++i)
#pragma unroll
      for (int e = 0; e < 4; ++e) {
        const int key = (q16 + i) * 16 + fq * 4 + e, rel = key - 128 - qloc, kpos = (nb - 1) * 128 + key;
        const bool valid = rel >= -128 && rel <= 128 && kpos >= 0 && kpos < L;
        sc[i][e] = valid ? sc[i][e] : -1e30f;
        m = fmaxf(m, sc[i][e]);
      }
    m = fmaxf(m, __shfl_xor(m, 16)); m = fmaxf(m, __shfl_xor(m, 32));
    float sum = 0.f;
#pragma unroll
    for (int i = 0; i < 17; ++i)
#pragma unroll
      for (int e = 0; e < 4; ++e) { const float pv = __expf(sc[i][e] - m); sc[i][e] = pv; sum += pv; }
    sum += __shfl_xor(sum, 16); sum += __shfl_xor(sum, 32);
    const float rden = 1.f / (sum + __expf(sink - m));
    f32x4 o[4];
#pragma unroll
    for (int dt = 0; dt < 4; ++dt) o[dt] = (f32x4){0.f, 0.f, 0.f, 0.f};
#pragma unroll
    for (int mm = 0; mm < 9; ++mm) {
      bf16x8 pf;
#pragma unroll
      for (int e = 0; e < 4; ++e) { pf[e] = (short)f2bf(sc[2 * mm][e]); pf[4 + e] = mm < 8 ? (short)f2bf(sc[mm < 8 ? 2 * mm + 1 : 16][e]) : (short)0; }
      const int k0 = (q16 + 2 * mm) * 16 + fq * 4, k1 = (mm < 8 ? (q16 + 2 * mm + 1) : q16) * 16 + fq * 4;
#pragma unroll
      for (int dt = 0; dt < 4; ++dt) {
        const bf16_t* vr = VT + (dt * 16 + fr) * 392;
        const uint2 lo = *(const uint2*)(vr + k0), hi = *(const uint2*)(vr + k1);
        uint4 pk = make_uint4(lo.x, lo.y, hi.x, hi.y);
        o[dt] = MFMA16(__builtin_bit_cast(bf16x8, pk), pf, o[dt]);
      }
    }
#pragma unroll
    for (int dt = 0; dt < 4; ++dt) {
      const int d0 = dt * 16 + fq * 4;
      const uint2 gv = *(const uint2*)(U + tokq * OD_IN + 768 + hq * 64 + d0);
      const float g0 = __uint_as_float(gv.x << 16), g1 = __uint_as_float(gv.x & 0xffff0000u), g2 = __uint_as_float(gv.y << 16), g3 = __uint_as_float(gv.y & 0xffff0000u);
      uint2 ov; ov.x = pack2(o[dt][0] * rden * silu(g0), o[dt][1] * rden * silu(g1)); ov.y = pack2(o[dt][2] * rden * silu(g2), o[dt][3] * rden * silu(g3));
      *(uint2*)(H + tokq * D + hq * 64 + d0) = ov;
    }
  }
  __syncthreads();
}
#define XB_TMO      128
#define XB_XCNT(j)  (256  + 64 * (j))
#define XB_XSUB(j)  (1280 + 64 * (j))
#define XB_XGEN(j)  (2304 + 64 * (j))
#define XB_TOP      3328
#define XB_TOPGEN   3392
#define XCD_BAR_WORDS 3456
#define XB_SPIN_CAP (1u << 18)
#define XLAS __attribute__((address_space(3)))

__device__ __forceinline__ unsigned xb_ld(unsigned* p)              { return __hip_atomic_load(p, __ATOMIC_RELAXED, __HIP_MEMORY_SCOPE_AGENT); }
__device__ __forceinline__ unsigned xb_add(unsigned* p, unsigned v) { return __hip_atomic_fetch_add(p, v, __ATOMIC_RELAXED, __HIP_MEMORY_SCOPE_AGENT); }
__device__ __forceinline__ unsigned xb_xcc_id() { return (unsigned)__builtin_amdgcn_s_getreg((3 << 11) | 20) & 0xFu; }
#define XB_SPIN(cond, bar) do { unsigned _sp = 0; while (cond) { __builtin_amdgcn_s_sleep(1); \
    if ((++_sp & 255u) == 0u) { if (xb_ld(&(bar)[XB_TMO])) break; if (_sp > XB_SPIN_CAP) { atomicAdd(&(bar)[XB_TMO], 1u); break; } } } } while (0)

struct XcdBarrier {
    unsigned* bar; unsigned x;
    volatile XLAS unsigned* st;
};

__device__ __forceinline__ XcdBarrier xcd_barrier_post(unsigned* bar, volatile XLAS unsigned* st) {
    XcdBarrier b; b.bar = bar; b.x = xb_xcc_id(); b.st = st;
    if (threadIdx.x == 0) (void)xb_add(&bar[XB_XCNT(b.x)], 1u);
    return b;
}
__device__ __forceinline__ void xcd_barrier_complete(unsigned* bar, unsigned x, unsigned& nloc, unsigned& nx) {
    const unsigned G = gridDim.x * gridDim.y * gridDim.z;
    unsigned sum, cnt, mine, sp = 0u;
    for (;;) {
        sum = 0u; cnt = 0u; mine = 0u;
#pragma unroll
        for (unsigned j = 0; j < 16; ++j) { const unsigned c = xb_ld(&bar[XB_XCNT(j)]); sum += c; cnt += (c > 0u) ? 1u : 0u; mine = (j == x) ? c : mine; }
        if (sum == G) break;
        __builtin_amdgcn_s_sleep(1);
        if ((++sp & 255u) == 0u) { if (xb_ld(&bar[XB_TMO])) break; if (sp > XB_SPIN_CAP) { atomicAdd(&bar[XB_TMO], 1u); break; } }
    }
    nloc = mine > 0u ? mine : 1u; nx = cnt > 0u ? cnt : 1u;
}

__device__ __forceinline__ void xcd_barrier(const XcdBarrier& b) {
    asm volatile("s_waitcnt vmcnt(0)" ::: "memory");
    __syncthreads();
    if (threadIdx.x == 0) {
        unsigned* bar = b.bar;
        __builtin_amdgcn_s_waitcnt(0);
        unsigned nloc = b.st[0], nx = b.st[1];
        if (nloc == 0u) { xcd_barrier_complete(bar, b.x, nloc, nx); b.st[0] = nloc; b.st[1] = nx; }
        const unsigned old = xb_add(&bar[XB_XSUB(b.x)], 1u);
        const unsigned gen = old / nloc;
        if (old + 1u == (gen + 1u) * nloc) {
            __builtin_amdgcn_fence(__ATOMIC_RELEASE, "agent");
            asm volatile("s_waitcnt vmcnt(0)" ::: "memory");
            const unsigned og = xb_add(&bar[XB_TOP], 1u);
            const unsigned tg = og / nx;
            if (og + 1u == (tg + 1u) * nx) xb_add(&bar[XB_TOPGEN], 1u);
            else XB_SPIN(xb_ld(&bar[XB_TOPGEN]) == tg, bar);
            __builtin_amdgcn_fence(__ATOMIC_ACQUIRE, "agent");
            xb_add(&bar[XB_XGEN(b.x)], 1u);
            asm volatile("s_waitcnt vmcnt(0)" ::: "memory");
        } else {
            XB_SPIN(xb_ld(&bar[XB_XGEN(b.x)]) == gen, bar);
            __builtin_amdgcn_fence(__ATOMIC_ACQUIRE, "agent");
            asm volatile("s_waitcnt vmcnt(0)" ::: "memory");
        }
    }
    __syncthreads();
}


#ifndef PHMASK
#define PHMASK 0xFFF
#endif
DEVI int next_task(unsigned* cnt, int* sh) { __syncthreads(); if (threadIdx.x == 0) *sh = (int)atomicAdd(cnt, 1u); __syncthreads(); return *sh; }
DEVI void decode_chain(int id, int& s, int& rem) { if (id < 32) { s = id >> 4; rem = id & 15; } else { s = 2 + ((id - 32) >> 4); rem = (id - 32) & 15; } }

__global__ void __launch_bounds__(512, 2) mega(P p) {
  extern __shared__ __attribute__((aligned(16))) char smem[];
  __shared__ uint4 xb_words;
  if (threadIdx.x == 0) xb_words = make_uint4(0u, 0u, 0u, 0u);
  __syncthreads();
  const XcdBarrier xb = xcd_barrier_post((unsigned*)(p.ws + OFF_BAR), (volatile XLAS unsigned*)&xb_words);
  int& sh_task = *((int*)&xb_words + 2);
  cg::grid_group grid = cg::this_grid();
  unsigned* cnt = (unsigned*)(p.ws + OFF_CNT);
  const bf16_t* Hc = (const bf16_t*)(p.ws + OFF_H);
  const float* MOD = (const float*)(p.ws + OFF_MOD);
#ifndef DUPMASK
#define DUPMASK 0
#endif
#define PH_ON(k) ((PHMASK & (1 << (k))) && p.ph_lo <= (k) && (k) < p.ph_hi)
#define REP(k) for (int rep_ = 0; rep_ < ((DUPMASK >> (k)) & 1) + 1; ++rep_)
#define PH_SYNC(k) if (p.ph_lo <= (k) && (k) + 1 < p.ph_hi) { if ((k) == 0) grid.sync(); else xcd_barrier(xb); }
  if (PH_ON(0)) REP(0) phase_prep(p, smem);
  PH_SYNC(0);
  if (PH_ON(1)) REP(1) phase_modulate0(p);
  PH_SYNC(1);
  if (PH_ON(2)) REP(2) { EpiU e{(bf16_t*)(p.ws + OFF_U), EV_IN, EV_IN, (const float*)(p.ws + OFF_LB), 1}; gemm_phase(Hc, (const bf16_t*)(p.ws + OFF_WIN0), NTOK, EV_PAD, D, e, smem); }
  PH_SYNC(2);
#ifndef DUP3
#define DUP3 1
#endif
#ifndef DUP8
#define DUP8 1
#endif
  if (PH_ON(3)) {
    int id;
    while ((id = next_task(cnt + 2, &sh_task)) < 224) {
      const int ci = id / 7, g = id % 7, s = ci >> 4, rem = ci & 15, h = (rem >> 1) & 3, dir = rem & 1;
      if ((rem >> 3) == 0) scan0_task<128, 0, 1>(p, smem, s, h, dir, g * 32, 32, ci * 7, g); else scan0_task<64, 1, 1>(p, smem, s, h, dir, g * 32, 32, ci * 7, g);
    }
    xcd_barrier(xb);
    while ((id = next_task(cnt + 3, &sh_task)) < 512) {
      int s, rem, n0 = 0, nc = 64, sb = 0, g = 0;
      if (id < 256) { s = 2 + (id >> 4); rem = id & 15; }
      else { const int a = id - 256, ci = a >> 3; g = a & 7; s = ci >> 4; rem = ci & 15; n0 = g * 32; nc = 32; sb = ci * 7; }
      const int h = (rem >> 1) & 3, dir = rem & 1;
      if ((rem >> 3) == 0) scan0_task<128, 0, 0>(p, smem, s, h, dir, n0, nc, sb, g); else scan0_task<64, 1, 0>(p, smem, s, h, dir, n0, nc, sb, g);
    }
  }
  PH_SYNC(3);
  if (PH_ON(4)) phase_combine0(p);
  PH_SYNC(4);
  if (PH_ON(5)) REP(5) { EpiU e{(bf16_t*)(p.ws + OFF_U), D, D, (const float*)(p.ws + OFF_LB), 0}; gemm_phase(Hc, (const bf16_t*)(p.ws + OFF_WOUT0), NTOK, D, D, e, smem); }
  PH_SYNC(5);
  if (PH_ON(6)) phase_ln(p, 0);
  PH_SYNC(6);
  if (PH_ON(7)) REP(7) { EpiU e{(bf16_t*)(p.ws + OFF_U), OD_IN, OD_IN, (const float*)(p.ws + OFF_LB), 0}; gemm_phase(Hc, (const bf16_t*)(p.ws + OFF_WIN1), NTOK, OD_PAD, D, e, smem); }
  PH_SYNC(7);
  if (PH_ON(8)) {
    int id;
#ifndef NO_R0
    while ((id = next_task(cnt + 16, &sh_task)) < 256) { if (id & 1) rwkv_task<0, 1>(p, smem, 2 + (id >> 4), (id & 15) >> 1, 0, 64, 0, 0); else rwkv_task<0, 0>(p, smem, 2 + (id >> 4), (id & 15) >> 1, 0, 64, 0, 0); }
#endif
#ifndef NO_R1
    while ((id = next_task(cnt + 19, &sh_task)) < 224) { const int ci = id / 7, g = id % 7; if (ci & 1) rwkv_task<1, 1>(p, smem, ci >> 4, (ci & 15) >> 1, g * 32, 32, ci * 7, g); else rwkv_task<1, 0>(p, smem, ci >> 4, (ci & 15) >> 1, g * 32, 32, ci * 7, g); }
#endif
    while ((id = next_task(cnt + 18, &sh_task)) < 768) attn_task(p, smem, id >> 1, id & 1);
    xcd_barrier(xb);
#ifndef NO_R2
    while ((id = next_task(cnt + 17, &sh_task)) < 256) { const int ci = id >> 3, g = id & 7; if (ci & 1) rwkv_task<0, 1>(p, smem, ci >> 4, (ci & 15) >> 1, g * 32, 32, ci * 7, g); else rwkv_task<0, 0>(p, smem, ci >> 4, (ci & 15) >> 1, g * 32, 32, ci * 7, g); }
#endif
    while ((id = next_task(cnt + 20, &sh_task)) < 768) attn_task(p, smem, (id + 768) >> 1, id & 1);
  }
  PH_SYNC(8);
  if (PH_ON(9)) phase_rwkv_post(p);
  PH_SYNC(9);
  if (PH_ON(10)) { EpiU e{(bf16_t*)(p.ws + OFF_U), D, D, (const float*)(p.ws + OFF_LB), 0}; gemm_phase(Hc, (const bf16_t*)(p.ws + OFF_WOUT1), NTOK, D, D, e, smem); }
  PH_SYNC(10);
  if (PH_ON(11)) phase_ln(p, 1);
}

constexpr int NPH = 12;
constexpr bool ONE_LAUNCH = true;
extern "C" void kernel_launch(void* const* d_in, const int* in_sizes, int n_in, void* d_out, int out_size, void* d_ws, size_t ws_size, hipStream_t stream) {
  P p{};
  const float** f = (const float**)&p;
  for (int i = 0; i < 32; ++i) f[i] = (const float*)d_in[i];
  p.out = (float*)d_out; p.ws = (unsigned char*)d_ws; p.ph_lo = 0; p.ph_hi = NPH;
  static int grid_blocks = 0;
  if (!grid_blocks) {
    (void)hipFuncSetAttribute((const void*)mega, hipFuncAttributeMaxDynamicSharedMemorySize, LDS_BYTES);
    int dev = 0, cus = 0, per_cu = 0;
    (void)hipGetDevice(&dev);
    (void)hipDeviceGetAttribute(&cus, hipDeviceAttributeMultiprocessorCount, dev);
    (void)hipOccupancyMaxActiveBlocksPerMultiprocessor(&per_cu, mega, NTHR, LDS_BYTES);
    if (per_cu > 1) per_cu = 1;
    grid_blocks = cus * per_cu;
  }
  if (ws_size < WS_NEED || grid_blocks <= 0) { fprintf(stderr, "ws too small or no occupancy: %zu < %zu, grid %d\n", ws_size, WS_NEED, grid_blocks); return; }
  if (ONE_LAUNCH) {
    (void)hipMemsetAsync((unsigned char*)d_ws + OFF_BAR, 0, 16384, stream);
    void* args[] = {&p};
    hipError_t e = hipLaunchCooperativeKernel((void*)mega, dim3(grid_blocks), dim3(NTHR), args, LDS_BYTES, stream);
    if (e != hipSuccess) fprintf(stderr, "cooperative launch failed: %s (grid %d)\n", hipGetErrorString(e), grid_blocks);
  } else {
    for (int ph = 0; ph < NPH; ++ph) { P q = p; q.ph_lo = ph; q.ph_hi = ph + 1; hipLaunchKernelGGL(mega, dim3(grid_blocks), dim3(NTHR), LDS_BYTES, stream, q); }
  }
}
```
